# Optimizing an MI355X kernel written in HIP

```python
import jax, jax.numpy as jnp
from jax import lax
import numpy as np

D_MODEL = 2048
BATCH = 4
SEQ = 2048
DEPTH = 1
DEC_BATCH = 128
DEC_SEQ = 8
PAST_LEN = 16384
PAGE_SIZE = 128

EXPAND = 2
D_MIX = EXPAND * D_MODEL
W_CONV = D_MIX // 2
W_HGRN = D_MIX - W_CONV
CONV_GROUPS = 16
CONV_WIDTH = 3
HGRN_DK = 128
HGRN_HEADS = W_HGRN // HGRN_DK
HGRN_DV = W_HGRN // HGRN_HEADS
CHUNK = 64
N_PROJ = 4 * W_CONV + 4 * W_HGRN
DEEPNORM_ALPHA = (2.0 * DEPTH) ** 0.25
DEEPNORM_BETA = (8.0 * DEPTH) ** -0.25
EPS = 1e-5

kernel_name = "hymba_conv_hgrn2_deepnorm_step"

_SPLITS = [W_CONV, 2 * W_CONV, 3 * W_CONV, 4 * W_CONV,
           4 * W_CONV + W_HGRN, 4 * W_CONV + 2 * W_HGRN, 4 * W_CONV + 3 * W_HGRN]


def _group_rms(x, gain, n_groups):
    shp = x.shape
    xf = x.astype(jnp.float32).reshape(shp[:-1] + (n_groups, shp[-1] // n_groups))
    xf = xf * lax.rsqrt(jnp.mean(xf * xf, axis=-1, keepdims=True) + EPS)
    return xf.reshape(shp) * gain.astype(jnp.float32)


def _layer_norm(x, gain, bias):
    xf = x.astype(jnp.float32)
    mu = jnp.mean(xf, axis=-1, keepdims=True)
    xc = xf - mu
    var = jnp.mean(xc * xc, axis=-1, keepdims=True)
    return xc * lax.rsqrt(var + EPS) * gain.astype(jnp.float32) + bias.astype(jnp.float32)


def _short_conv(u, buf, w):
    T = u.shape[1]
    ext = jnp.concatenate([buf.astype(u.dtype), u], axis=1)
    y = sum(ext[:, j:j + T] * w[j] for j in range(CONV_WIDTH))
    new_buf = ext[:, ext.shape[1] - (CONV_WIDTH - 1):]
    return y, new_buf


def _hgrn2_chunked(q, k, v, g, s0):
    bsz, T = q.shape[0], q.shape[1]
    n_c = -(-T // CHUNK)
    pad = n_c * CHUNK - T
    if pad:
        pw = ((0, 0), (0, pad), (0, 0), (0, 0))
        q, k, v, g = (jnp.pad(a, pw) for a in (q, k, v, g))
    rs = lambda a: a.reshape(bsz, n_c, CHUNK, HGRN_HEADS, a.shape[-1])
    q, k, v, g = rs(q), rs(k), rs(v), rs(g)
    b = jnp.cumsum(g, axis=2)
    b_last = b[:, :, -1]
    q_e = q * jnp.exp(b)
    k_e = k * jnp.exp(-b)
    k_t = k * jnp.exp(b_last[:, :, None] - b)
    scores = jnp.einsum('bnthk,bnshk->bnhts', q_e, k_e)
    causal = jnp.tril(jnp.ones((CHUNK, CHUNK), dtype=bool))
    scores = jnp.where(causal, scores, 0.0)
    o_intra = jnp.einsum('bnhts,bnshv->bnthv', scores, v)

    def step(S, xs):
        qe_c, kt_c, v_c, dl_c = xs
        o = jnp.einsum('bthk,bhkv->bthv', qe_c, S)
        S = dl_c[..., None] * S + jnp.einsum('bshk,bshv->bhkv', kt_c, v_c)
        return S, o

    xs = (jnp.moveaxis(q_e, 1, 0), jnp.moveaxis(k_t, 1, 0),
          jnp.moveaxis(v, 1, 0), jnp.moveaxis(jnp.exp(b_last), 1, 0))
    s_fin, o_inter = lax.scan(step, s0.astype(jnp.float32), xs)
    o = o_intra + jnp.moveaxis(o_inter, 0, 1)
    o = o.reshape(bsz, n_c * CHUNK, HGRN_HEADS, HGRN_DV)[:, :T]
    return o, s_fin


def _mixer_layer(x, conv_buf, hgrn_s, w_in, conv_w, norm_a, lb, norm_b, w_out, ln_g, ln_b):
    bsz, T, _ = x.shape
    proj = jnp.einsum('btd,de->bte', x, w_in)
    v_a, b_a, c_a, z_a, q_b, f_b, i_b, z_b = jnp.split(proj, _SPLITS, axis=-1)

    conv_out, new_buf = _short_conv(c_a * v_a, conv_buf, conv_w)
    y_a = _group_rms(b_a * conv_out, norm_a, CONV_GROUPS) * jax.nn.silu(z_a.astype(jnp.float32))

    hs = lambda a: a.astype(jnp.float32).reshape(bsz, T, HGRN_HEADS, -1)
    q = jax.nn.silu(hs(q_b)) * (HGRN_DK ** -0.5)
    f = lb + (1.0 - lb) * jax.nn.sigmoid(hs(f_b))
    o, new_s = _hgrn2_chunked(q, 1.0 - f, hs(i_b), jnp.log(f), hgrn_s)
    y_b = _group_rms(o.reshape(bsz, T, W_HGRN), norm_b, HGRN_HEADS) * jax.nn.silu(z_b.astype(jnp.float32))

    mix = jnp.concatenate([y_a, y_b], axis=-1).astype(x.dtype)
    h = jnp.einsum('bte,ed->btd', mix, w_out)
    y = _layer_norm(DEEPNORM_ALPHA * x.astype(jnp.float32) + h.astype(jnp.float32), ln_g, ln_b)
    return y.astype(x.dtype), new_buf.astype(conv_buf.dtype), new_s.astype(hgrn_s.dtype)


def setup_inputs(seed: int = 0) -> dict:
    key = jax.random.key(seed)
    ks = jax.random.split(key, 12)
    x_prompt = jax.random.normal(ks[0], (BATCH, SEQ, D_MODEL), jnp.float32)
    x_sample = jax.random.normal(ks[1], (DEC_BATCH, DEC_SEQ, D_MODEL), jnp.float32)
    state_conv = 0.3 * jax.random.normal(ks[2], (DEPTH, DEC_BATCH, CONV_WIDTH - 1, W_CONV), jnp.float32)
    state_hgrn = 0.1 * jax.random.normal(ks[3], (DEPTH, DEC_BATCH, HGRN_HEADS, HGRN_DK, HGRN_DV), jnp.float32)
    col_scale = jnp.concatenate([
        jnp.full((W_CONV,), DEEPNORM_BETA, jnp.float32), jnp.ones((3 * W_CONV,), jnp.float32),
        jnp.ones((2 * W_HGRN,), jnp.float32), jnp.full((W_HGRN,), DEEPNORM_BETA, jnp.float32),
        jnp.ones((W_HGRN,), jnp.float32)])
    w_in = jax.random.normal(ks[4], (DEPTH, D_MODEL, N_PROJ), jnp.float32) * (D_MODEL ** -0.5) * col_scale
    conv_w = jax.random.normal(ks[5], (DEPTH, CONV_WIDTH, W_CONV), jnp.float32) * (CONV_WIDTH ** -0.5)
    norm_a = 1.0 + 0.01 * jax.random.normal(ks[6], (DEPTH, W_CONV), jnp.float32)
    lb_logits = 0.1 * jax.random.normal(ks[7], (DEPTH + 1, W_HGRN), jnp.float32)
    norm_b = 1.0 + 0.01 * jax.random.normal(ks[8], (DEPTH, W_HGRN), jnp.float32)
    w_out = jax.random.normal(ks[9], (DEPTH, D_MIX, D_MODEL), jnp.float32) * (D_MIX ** -0.5) * DEEPNORM_BETA
    ln_gain = 1.0 + 0.01 * jax.random.normal(ks[10], (DEPTH, D_MODEL), jnp.float32)
    ln_bias = 0.01 * jax.random.normal(ks[11], (DEPTH, D_MODEL), jnp.float32)
    return {"x_prompt": x_prompt, "x_sample": x_sample, "state_conv": state_conv,
            "state_hgrn": state_hgrn, "w_in": w_in, "conv_w": conv_w, "norm_a": norm_a,
            "lb_logits": lb_logits, "norm_b": norm_b, "w_out": w_out,
            "ln_gain": ln_gain, "ln_bias": ln_bias}


def reference(x_prompt, x_sample, state_conv, state_hgrn, w_in, conv_w, norm_a, lb_logits,
              norm_b, w_out, ln_gain, ln_bias):
    lb_all = jnp.cumsum(jax.nn.softmax(lb_logits.astype(jnp.float32), axis=0), axis=0)
    yp, ys = x_prompt, x_sample
    conv_p_list, hgrn_p_list, conv_s_list, hgrn_s_list = [], [], [], []
    for l in range(DEPTH):
        lb = lb_all[l].reshape(HGRN_HEADS, HGRN_DK)
        params = (w_in[l], conv_w[l], norm_a[l], lb, norm_b[l], w_out[l], ln_gain[l], ln_bias[l])
        zero_buf = jnp.zeros((BATCH, CONV_WIDTH - 1, W_CONV), state_conv.dtype)
        zero_s = jnp.zeros((BATCH, HGRN_HEADS, HGRN_DK, HGRN_DV), state_hgrn.dtype)
        yp, cb_p, s_p = _mixer_layer(yp, zero_buf, zero_s, *params)
        ys, cb_s, s_s = _mixer_layer(ys, state_conv[l], state_hgrn[l], *params)
        conv_p_list.append(cb_p)
        hgrn_p_list.append(s_p)
        conv_s_list.append(cb_s)
        hgrn_s_list.append(s_s)
    new_conv_prompt = jnp.stack(conv_p_list, axis=0)
    new_hgrn_prompt = jnp.stack(hgrn_p_list, axis=0)
    new_conv_sample = jnp.stack(conv_s_list, axis=0)
    new_hgrn_sample = jnp.stack(hgrn_s_list, axis=0)
    return (yp, ys, new_conv_prompt, new_hgrn_prompt, new_conv_sample, new_hgrn_sample)
```

```cpp
#include <hip/hip_runtime.h>
namespace pg8 {
#define PG8_LAS __attribute__((address_space(3)))
typedef unsigned short bf16_t;
typedef short bf16x8 __attribute__((ext_vector_type(8)));
typedef float f32x4 __attribute__((ext_vector_type(4)));
typedef unsigned u32x4 __attribute__((ext_vector_type(4)));
constexpr int BM = 256, BK = 64, HALF = 128, HTB = HALF * BK * 2  , STAGE_BYTES = 8 * HTB, NXCD = 8, WGM = 8;

__host__ __device__ __forceinline__ int lds_byte(int r, int c) { const int st = (r >> 4) * 2 + (c >> 5), rr = r & 15, cc = c & 31, ob = rr * 64 + cc * 2; return st * 1024 + (ob ^ (((ob >> 9) & 1) << 5)); }
__host__ __device__ __forceinline__ void stage_rc(int b, int& R, int& C) { const int st = b / 1024, sb = b % 1024, swz = sb ^ (((sb >> 9) & 1) << 5); R = (st >> 1) * 16 + swz / 64; C = (st & 1) * 32 + (swz % 64) / 2; }
__host__ __device__ __forceinline__ int perm32(int rho) { const int n = rho >> 4, i = rho & 15; return 8 * (i >> 2) + 4 * n + (i & 3); }

struct Unit { int pm, pn; };
struct Gemm { const bf16_t* A; const bf16_t* Bt; int M, N, K; };

struct StaticOrder {
    int nM, nN, nwg, G, c;
    __host__ __device__ void init(int M, int N, int G_, int c_) { nM = M / BM; nN = N / BM; nwg = nM * nN; G = G_; c = c_; }
    __host__ __device__ bool next(int i, Unit& u) const {
        const long L = (long)i * G + c; if (L >= nwg) return false;
        int wgid = (int)L; { const int q = nwg / NXCD, r = nwg % NXCD, xcd = wgid % NXCD, off = wgid / NXCD; wgid = (xcd < r ? xcd * (q + 1) : r * (q + 1) + (xcd - r) * q) + off; }
        const int nig = WGM * nN, gid = wgid / nig, fm = gid * WGM, gsz = (nM - fm) < WGM ? (nM - fm) : WGM;
        u.pm = fm + ((wgid % nig) % gsz); u.pn = (wgid % nig) / gsz; return true;
    }
    __device__ __forceinline__ void a_ready(const Unit&) const {}
    __device__ __forceinline__ void done(const Unit&) const {}
};
__device__ __forceinline__ unsigned cvt_pk_bf16(float lo, float hi) { unsigned r; asm volatile("v_cvt_pk_bf16_f32 %0, %1, %2" : "=v"(r) : "v"(lo), "v"(hi)); return r; }
typedef float f32x2 __attribute__((ext_vector_type(2)));
__device__ __forceinline__ f32x2 gelu_pk(f32x2 v) {
    const f32x2 av = __builtin_elementwise_abs(v), d = av * 0.2316418882f + 1.0f;
    f32x2 t; t.x = __builtin_amdgcn_rcpf(d.x); t.y = __builtin_amdgcn_rcpf(d.y);
    f32x2 q = t * 0.5307027145f + (-0.7265760135f); q = q * t + 0.7107068705f; q = q * t + (-0.142248368f); q = q * t + 0.127414796f; q = q * t;
    const f32x2 s = (v * v) * (-0.72134752044f);
    f32x2 e; e.x = __builtin_amdgcn_exp2f(s.x); e.y = __builtin_amdgcn_exp2f(s.y);
    const f32x2 m = v * (q * e), r = v - m;
    f32x2 o; o.x = v.x < 0.f ? m.x : r.x; o.y = v.y < 0.f ? m.y : r.y; return o;
}

struct EpiF32 {
    static constexpr bool PERM = false, AFTER_DRAIN = false;
    float* C; int ldc; const float* bias;
    __device__ __forceinline__ void operator()(const f32x4 (&acc)[2][2][4][2], const Unit& u, int wr, int wc, int fr, int fq) const {
        const int row0 = u.pm * BM + wr * 64 + fr, col0 = u.pn * BM + wc * 32 + 4 * fq;
        f32x4 bv[2][2];
#pragma unroll
        for (int bj = 0; bj < 2; ++bj)
#pragma unroll
            for (int n = 0; n < 2; ++n) bv[bj][n] = bias ? *(const f32x4*)(bias + col0 + bj * HALF + n * 16) : (f32x4){0.f, 0.f, 0.f, 0.f};
#pragma unroll
        for (int ai = 0; ai < 2; ++ai)
#pragma unroll
            for (int m = 0; m < 4; ++m) { float* rowp = C + (size_t)(row0 + ai * HALF + m * 16) * ldc + col0;
#pragma unroll
                for (int bj = 0; bj < 2; ++bj)
#pragma unroll
                    for (int n = 0; n < 2; ++n) *(f32x4*)(rowp + bj * HALF + n * 16) = acc[ai][bj][m][n] + bv[bj][n]; }
    }
};
template <int ACT  > struct EpiBf16 {
    static constexpr bool PERM = true, AFTER_DRAIN = false;
    bf16_t* O; int ldc; const float* bias; int split_cols; size_t split_stride;
    __device__ __forceinline__ void operator()(const f32x4 (&acc)[2][2][4][2], const Unit& u, int wr, int wc, int fr, int fq) const {
        const int row0 = u.pm * BM + wr * 64 + fr; int colt = u.pn * BM; bf16_t* base = O;
        if (split_cols) { const int t = colt / split_cols; base += (size_t)t * split_stride; colt -= t * split_cols; }
        const int col0 = colt + wc * 32 + 8 * fq, bcol0 = u.pn * BM + wc * 32 + 8 * fq;
        f32x4 bv[2][2];
#pragma unroll
        for (int bj = 0; bj < 2; ++bj)
#pragma unroll
            for (int n = 0; n < 2; ++n) bv[bj][n] = bias ? *(const f32x4*)(bias + bcol0 + bj * HALF + 4 * n) : (f32x4){0.f, 0.f, 0.f, 0.f};
#pragma unroll
        for (int ai = 0; ai < 2; ++ai)
#pragma unroll
            for (int m = 0; m < 4; ++m) { bf16_t* rowp = base + (size_t)(row0 + ai * HALF + m * 16) * ldc + col0;
#pragma unroll
                for (int bj = 0; bj < 2; ++bj) { f32x4 v0 = acc[ai][bj][m][0] + bv[bj][0], v1 = acc[ai][bj][m][1] + bv[bj][1];
                    if (ACT == 1) { f32x2 a = gelu_pk((f32x2){v0[0], v0[1]}), b = gelu_pk((f32x2){v0[2], v0[3]}), c = gelu_pk((f32x2){v1[0], v1[1]}), d = gelu_pk((f32x2){v1[2], v1[3]});
                        v0 = (f32x4){a.x, a.y, b.x, b.y}; v1 = (f32x4){c.x, c.y, d.x, d.y}; }
                    if (ACT == 2) {
#pragma unroll
                        for (int j = 0; j < 4; ++j) { v0[j] = 0.5f * v0[j] * (1.0f + erff(v0[j] * 0.70710678f)); v1[j] = 0.5f * v1[j] * (1.0f + erff(v1[j] * 0.70710678f)); } }
                    u32x4 w; w.x = cvt_pk_bf16(v0[0], v0[1]); w.y = cvt_pk_bf16(v0[2], v0[3]); w.z = cvt_pk_bf16(v1[0], v1[1]); w.w = cvt_pk_bf16(v1[2], v1[3]);
                    *(u32x4*)(rowp + bj * HALF) = w; } }
    }
};

template <class Epi, class Sched, bool STAMP = false>
__device__ __forceinline__ void gemm_phase(PG8_LAS unsigned char* lds, const Gemm g, const Sched& S, const Epi& E, unsigned long long* stamps) {
    const int tid = threadIdx.x, wid = __builtin_amdgcn_readfirstlane(tid >> 6), lane = tid & 63, wr = wid >> 2, wc = wid & 3, fr = lane & 15, fq = lane >> 4;
    const int K = g.K, nt = K / BK;
    int ts_lo = 0, ts_hi = 0, nts = 0; const unsigned long long rt_entry = STAMP ? (unsigned long long)wall_clock64() : 0ull;
#define PG8_STAMP() do { if (STAMP && wid == 0 && nts < 64) { const unsigned long long _c = (unsigned long long)clock64(); \
        ts_lo = (lane == nts) ? (int)(unsigned)_c : ts_lo; ts_hi = (lane == nts) ? (int)(unsigned)(_c >> 32) : ts_hi; ++nts; } } while (0)
    PG8_STAMP();
    unsigned voffA[2], voffB[2];
#pragma unroll
    for (int i = 0; i < 2; ++i) { int R, C; stage_rc(tid * 16 + i * 8192, R, C); const int Rb = Epi::PERM ? ((R & ~31) + perm32(R & 31)) : R;
        voffA[i] = (unsigned)(R * K + C) * 2u; voffB[i] = (unsigned)(Rb * K + C) * 2u; }
    const size_t kstep = (size_t)(BK * 2);
    const size_t hstep = (size_t)HALF * K * 2;
    const size_t tstep = 2 * hstep;
    const unsigned ldsw = (unsigned)wid * 1024u;
    const int aoff = lds_byte(wr * 64 + fr, fq * 8), boff = lds_byte(wc * 32 + fr, fq * 8);
#define PG8_SA(b, h) (((b) * 2 + (h)) * HTB)
#define PG8_SB(b, h) ((4 + (b) * 2 + (h)) * HTB)
#define PG8_STAGE(bufoff, gbase, voff) do { _Pragma("unroll") for (int _i = 0; _i < 2; ++_i) \
        __builtin_amdgcn_global_load_lds((const unsigned*)((const char*)(gbase) + (voff)[_i]), (PG8_LAS unsigned*)(lds + (bufoff) + ldsw + _i * 8192), 16, 0, 0); } while (0)
#define PG8_LDA(dst, b, h) do { _Pragma("unroll") for (int m = 0; m < 4; ++m) _Pragma("unroll") for (int k = 0; k < 2; ++k) dst[m][k] = *(const PG8_LAS bf16x8*)(lds + PG8_SA(b, h) + aoff + m * 2048 + k * 1024); } while (0)
#define PG8_LDB(dst, b, h) do { _Pragma("unroll") for (int n = 0; n < 2; ++n) _Pragma("unroll") for (int k = 0; k < 2; ++k) dst[n][k] = *(const PG8_LAS bf16x8*)(lds + PG8_SB(b, h) + boff + n * 2048 + k * 1024); } while (0)
#define PG8_MMA(ai, bj, At, Bt) do { __builtin_amdgcn_s_setprio(1); _Pragma("unroll") for (int m = 0; m < 4; ++m) _Pragma("unroll") for (int n = 0; n < 2; ++n) _Pragma("unroll") for (int k = 0; k < 2; ++k) \
        acc[ai][bj][m][n] = __builtin_amdgcn_mfma_f32_16x16x32_bf16(Bt[n][k], At[m][k], acc[ai][bj][m][n], 0, 0, 0); __builtin_amdgcn_s_setprio(0); } while (0)
#define PG8_WAIT_V(n) asm volatile("s_waitcnt vmcnt(" #n ")" ::: "memory")
#define PG8_WAIT_L(n) asm volatile("s_waitcnt lgkmcnt(" #n ")" ::: "memory")
#define PG8_BAR __builtin_amdgcn_s_barrier()
#define PG8_SCHED __builtin_amdgcn_sched_barrier(0)
    Unit cur, nxt; int ui = 0;
    if (!S.next(0, cur)) return;
    f32x4 acc[2][2][4][2];
#pragma unroll
    for (int a = 0; a < 2; ++a)
#pragma unroll
        for (int b = 0; b < 2; ++b)
#pragma unroll
            for (int m = 0; m < 4; ++m)
#pragma unroll
                for (int n = 0; n < 2; ++n) acc[a][b][m][n] = (f32x4){0.f, 0.f, 0.f, 0.f};
    bf16x8 At[4][2], B0[2][2], B1[2][2];
    const char* cA = (const char*)g.A + (size_t)cur.pm * tstep; const char* cB = (const char*)g.Bt + (size_t)cur.pn * tstep;
    S.a_ready(cur);
    PG8_STAGE(PG8_SB(0, 0), cB, voffB); PG8_STAGE(PG8_SA(0, 0), cA, voffA); PG8_STAGE(PG8_SB(0, 1), cB + hstep, voffB); PG8_STAGE(PG8_SA(0, 1), cA + hstep, voffA);
    if (wr == 1) PG8_BAR;
    PG8_WAIT_V(4); PG8_BAR;
    PG8_STAGE(PG8_SB(1, 0), cB + kstep, voffB); PG8_STAGE(PG8_SA(1, 0), cA + kstep, voffA); PG8_STAGE(PG8_SB(1, 1), cB + hstep + kstep, voffB);
    PG8_WAIT_V(6); PG8_BAR;
    PG8_STAMP();
    for (;;) {
        const bool has_next = S.next(ui + 1, nxt);
        const char* nA = has_next ? (const char*)g.A + (size_t)nxt.pm * tstep : cA; const char* nB = has_next ? (const char*)g.Bt + (size_t)nxt.pn * tstep : cB;
        for (int t = 0; t < nt; t += 2) {
            const bool last = (t == nt - 2);
            const char* a1 = cA + (size_t)(t + 1) * kstep;
            const char* a2 = last ? nA : cA + (size_t)(t + 2) * kstep; const char* b2 = last ? nB : cB + (size_t)(t + 2) * kstep;
            const char* a3 = a2 + kstep; const char* b3 = b2 + kstep;
            if (last && has_next) S.a_ready(nxt);
            PG8_LDB(B0, 0, 0); PG8_SCHED; PG8_LDA(At, 0, 0); PG8_STAGE(PG8_SA(1, 1), a1 + hstep, voffA);
            PG8_WAIT_L(8); PG8_BAR; PG8_WAIT_L(0); PG8_MMA(0, 0, At, B0); PG8_BAR; PG8_SCHED;
            PG8_LDB(B1, 0, 1); PG8_STAGE(PG8_SB(0, 0), b2, voffB);
            PG8_BAR; PG8_WAIT_L(0); PG8_MMA(0, 1, At, B1); PG8_BAR;
            PG8_LDA(At, 0, 1); PG8_STAGE(PG8_SA(0, 0), a2, voffA);
            PG8_BAR; PG8_WAIT_L(0); PG8_MMA(1, 0, At, B0); PG8_BAR; PG8_SCHED;
            PG8_STAGE(PG8_SB(0, 1), b2 + hstep, voffB);
            PG8_WAIT_V(6); PG8_BAR; PG8_MMA(1, 1, At, B1); PG8_BAR;
            PG8_LDB(B0, 1, 0); PG8_SCHED; PG8_LDA(At, 1, 0); PG8_STAGE(PG8_SA(0, 1), a2 + hstep, voffA);
            PG8_WAIT_L(8); PG8_BAR; PG8_WAIT_L(0); PG8_MMA(0, 0, At, B0); PG8_BAR; PG8_SCHED;
            PG8_LDB(B1, 1, 1); PG8_STAGE(PG8_SB(1, 0), b3, voffB);
            PG8_BAR; PG8_WAIT_L(0); PG8_MMA(0, 1, At, B1); PG8_BAR;
            PG8_LDA(At, 1, 1); PG8_STAGE(PG8_SA(1, 0), a3, voffA);
            PG8_BAR; PG8_WAIT_L(0); PG8_MMA(1, 0, At, B0); PG8_BAR; PG8_SCHED;
            PG8_STAGE(PG8_SB(1, 1), b3 + hstep, voffB);
            PG8_WAIT_V(6); PG8_BAR; PG8_MMA(1, 1, At, B1); PG8_BAR;
        }
        PG8_STAMP();
        if constexpr (!Epi::AFTER_DRAIN) { E(acc, cur, wr, wc, fr, fq); S.done(cur); }
        PG8_STAMP();
        if (!has_next) break;
#pragma unroll
        for (int a = 0; a < 2; ++a)
#pragma unroll
            for (int b = 0; b < 2; ++b)
#pragma unroll
                for (int m = 0; m < 4; ++m)
#pragma unroll
                    for (int n = 0; n < 2; ++n) acc[a][b][m][n] = (f32x4){0.f, 0.f, 0.f, 0.f};
        cur = nxt; cA = nA; cB = nB; ++ui;
    }
    PG8_WAIT_V(0);
    if (wr == 0) PG8_BAR;
    PG8_BAR;
    if constexpr (Epi::AFTER_DRAIN) { E.fused(acc, cur, wr, wc, fr, fq, lds, wid, lane); S.done(cur); }
    PG8_STAMP();
    if (STAMP && wid == 0) { stamps[lane] = lane < nts ? (((unsigned long long)(unsigned)ts_hi << 32) | (unsigned)ts_lo) : 0ull;
        if (lane == 62) stamps[62] = rt_entry; if (lane == 63) stamps[63] = (unsigned long long)wall_clock64(); }
#undef PG8_STAMP
#undef PG8_SA
#undef PG8_SB
#undef PG8_STAGE
#undef PG8_LDA
#undef PG8_LDB
#undef PG8_MMA
#undef PG8_WAIT_V
#undef PG8_WAIT_L
#undef PG8_BAR
#undef PG8_SCHED
}
}

#include <cstdio>
#include <ctime>
#include <cstdlib>
#include <cstring>
#include <cmath>
#include <vector>
#include <algorithm>
#define CK(x) do { hipError_t e_ = (x); if (e_ != hipSuccess) { fprintf(stderr, "HIP %s:%d %s\n", __FILE__, __LINE__, hipGetErrorString(e_)); exit(2); } } while (0)
#include <hip/hip_cooperative_groups.h>
#include <cstdio>
namespace cg = cooperative_groups;
using pg8::bf16_t;
using pg8::cvt_pk_bf16;

constexpr int DM = 2048, NPROJ = 16384, DMIX = 4096;
constexpr int PROWS = 8192, SROWS = 1024, MROWS = 9216;
constexpr int LDS_BYTES = 131072;
constexpr float EPSV = 1e-5f;
constexpr float ALPHA = 1.189207115002721f;
constexpr float QSCALE = 0.08838834764831845f;

constexpr size_t WS_A1 = 0;
constexpr size_t WS_BT1 = WS_A1 + (size_t)MROWS * DM * 2;
constexpr size_t WS_O = 0;
constexpr size_t WS_BT2 = WS_BT1 + (size_t)NPROJ * DM * 2;
constexpr size_t WS_PROJ = WS_BT2 + (size_t)DM * DMIX * 2;
constexpr size_t WS_H = WS_PROJ;
constexpr size_t WS_MIX = WS_PROJ + (size_t)MROWS * NPROJ * 2;
constexpr size_t WS_END = WS_MIX + (size_t)MROWS * DMIX * 2;

constexpr size_t OFF_Y = 0;
constexpr size_t OFF_NCP = (size_t)MROWS * DM;
constexpr size_t OFF_NHP = OFF_NCP + 4 * 2 * 2048;
constexpr size_t OFF_NCS = OFF_NHP + (size_t)4 * 16 * 128 * 128;
constexpr size_t OFF_NHS = OFF_NCS + (size_t)128 * 2 * 2048;

struct Params {
    const float* x_prompt; const float* x_sample; const float* state_conv; const float* state_hgrn;
    const float* w_in; const float* conv_w; const float* norm_a; const float* lb_logits; const float* norm_b;
    const float* w_out; const float* ln_gain; const float* ln_bias;
    float* out; unsigned char* ws;
    int ph_lo, ph_hi;
};

__device__ __forceinline__ float bflo(unsigned u) { return __uint_as_float(u << 16); }
__device__ __forceinline__ float bfhi(unsigned u) { return __uint_as_float(u & 0xffff0000u); }
__device__ __forceinline__ void unpack8(const uint4 r, float (&f)[8]) {
    f[0] = bflo(r.x); f[1] = bfhi(r.x); f[2] = bflo(r.y); f[3] = bfhi(r.y); f[4] = bflo(r.z); f[5] = bfhi(r.z); f[6] = bflo(r.w); f[7] = bfhi(r.w);
}
__device__ __forceinline__ uint4 pack8(const float (&f)[8]) {
    uint4 r; r.x = cvt_pk_bf16(f[0], f[1]); r.y = cvt_pk_bf16(f[2], f[3]); r.z = cvt_pk_bf16(f[4], f[5]); r.w = cvt_pk_bf16(f[6], f[7]); return r;
}
__device__ __forceinline__ float sigm(float x) { return 1.0f / (1.0f + __expf(-x)); }
__device__ __forceinline__ float silu(float x) { return x / (1.0f + __expf(-x)); }
__device__ __forceinline__ void lds_barrier() { asm volatile("s_waitcnt lgkmcnt(0)" ::: "memory"); __builtin_amdgcn_s_barrier(); asm volatile("" ::: "memory"); }
#define DPP_ROR(x, n) __builtin_bit_cast(float, __builtin_amdgcn_update_dpp(0, __builtin_bit_cast(int, (x)), 0x120 + (n), 0xF, 0xF, true))
__device__ __forceinline__ float row16_sum(float x) { x += DPP_ROR(x, 8); x += DPP_ROR(x, 4); x += DPP_ROR(x, 2); x += DPP_ROR(x, 1); return x; }

__device__ __forceinline__ void p0_tile_info(const Params& p, int tile, const float*& src, int& ld, bf16_t*& dst, int& ldd) {
    if (tile < 2048) { const int kt = tile >> 6, nt = tile & 63; src = p.w_in + (size_t)(kt * 64) * NPROJ + nt * 256; ld = NPROJ;
        dst = (bf16_t*)(p.ws + WS_BT1) + (size_t)(nt * 256) * DM + kt * 64; ldd = DM; }
    else { const int t2 = tile - 2048, kt = t2 >> 3, nt = t2 & 7; src = p.w_out + (size_t)(kt * 64) * DM + nt * 256; ld = DM;
        dst = (bf16_t*)(p.ws + WS_BT2) + (size_t)(nt * 256) * DMIX + kt * 64; ldd = DMIX; }
}
__device__ void phase0(const Params& p, unsigned char* lds) {
    float* T = (float*)lds;
    const int tid = threadIdx.x;
    constexpr int NT = 2048 + 512;
    pg8::f32x4 r[8];
    int tile = blockIdx.x;
    const float* src = nullptr; int ld = 0; bf16_t* dst = nullptr; int ldd = 0;
    p0_tile_info(p, tile < NT ? tile : NT - 1, src, ld, dst, ldd);
#pragma unroll
    for (int i = 0; i < 8; ++i) r[i] = *(const pg8::f32x4*)(src + (size_t)(i * 8 + (tid >> 6)) * ld + (tid & 63) * 4);
    while (tile < NT) {
#pragma unroll
        for (int i = 0; i < 8; ++i) { const int k = i * 8 + (tid >> 6), n = (tid & 63) * 4; *(pg8::f32x4*)&T[k * 256 + (n ^ (i << 3))] = r[i]; }
        bf16_t* cdst = dst; const int cldd = ldd;
        const int nxt = tile + gridDim.x;
        p0_tile_info(p, nxt < NT ? nxt : NT - 1, src, ld, dst, ldd);
#pragma unroll
        for (int i = 0; i < 8; ++i) r[i] = *(const pg8::f32x4*)(src + (size_t)(i * 8 + (tid >> 6)) * ld + (tid & 63) * 4);
        lds_barrier();
#pragma unroll
        for (int c = 0; c < 4; ++c) { const int q = tid + 512 * c, n = q >> 3, k8 = q & 7; float v[8];
#pragma unroll
            for (int j = 0; j < 8; ++j) v[j] = T[(k8 * 8 + j) * 256 + (n ^ (k8 << 3))];
            *(uint4*)(cdst + (size_t)n * cldd + k8 * 8) = pack8(v); }
        lds_barrier();
        tile = nxt;
    }
    bf16_t* A1 = (bf16_t*)(p.ws + WS_A1);
    constexpr size_t total8 = (size_t)MROWS * DM / 8, pe = (size_t)PROWS * DM;
    const size_t stride = (size_t)gridDim.x * 512;
    for (size_t i = (size_t)blockIdx.x * 512 + tid; i < total8; i += 3 * stride) {
        const size_t i0 = i, i1 = i + stride, i2 = i + 2 * stride;
        const size_t j1 = i1 < total8 ? i1 : i0, j2 = i2 < total8 ? i2 : i0;
        const size_t e0 = i0 * 8, e1 = j1 * 8, e2 = j2 * 8;
        const float* s0 = e0 < pe ? p.x_prompt + e0 : p.x_sample + (e0 - pe);
        const float* s1 = e1 < pe ? p.x_prompt + e1 : p.x_sample + (e1 - pe);
        const float* s2 = e2 < pe ? p.x_prompt + e2 : p.x_sample + (e2 - pe);
        const float4 a0 = *(const float4*)s0, b0 = *(const float4*)(s0 + 4), a1 = *(const float4*)s1, b1 = *(const float4*)(s1 + 4), a2 = *(const float4*)s2, b2 = *(const float4*)(s2 + 4);
        { const float v[8] = {a0.x, a0.y, a0.z, a0.w, b0.x, b0.y, b0.z, b0.w}; *(uint4*)(A1 + e0) = pack8(v); }
        if (i1 < total8) { const float v[8] = {a1.x, a1.y, a1.z, a1.w, b1.x, b1.y, b1.z, b1.w}; *(uint4*)(A1 + e1) = pack8(v); }
        if (i2 < total8) { const float v[8] = {a2.x, a2.y, a2.z, a2.w, b2.x, b2.y, b2.z, b2.w}; *(uint4*)(A1 + e2) = pack8(v); }
    }
}

__device__ void hgrn_prompt_item(const Params& p, unsigned char* lds, int it) {
    const int vs = it & 3, h = (it >> 2) & 15, b = it >> 6;
    float* Q = (float*)lds; float* F = Q + 8192; float* V = F + 8192; float* O = V + 2048;
    const int tid = threadIdx.x, lane = tid & 63, w = tid >> 6, kg = lane & 15, vcol = w * 4 + (lane >> 4);
    const bf16_t* proj = (const bf16_t*)(p.ws + WS_PROJ);
    float* ows = (float*)(p.ws + WS_O);
    const size_t row0 = (size_t)b * 2048;
    const int pk = (tid & 15) * 8, pt = tid >> 4;
    float lbv[8];
    { const float* l0 = p.lb_logits + h * 128 + pk; const float* l1 = l0 + 2048;
#pragma unroll
      for (int j = 0; j < 8; ++j) lbv[j] = 1.0f / (1.0f + __expf(l1[j] - l0[j])); }
    const bf16_t* qbase = proj + row0 * NPROJ + 4 * 2048 + h * 128 + pk;
    const bf16_t* fbase = qbase + 2048;
    const int vt = tid >> 2, vv8 = (tid & 3) * 8;
    const bf16_t* vbase = proj + row0 * NPROJ + 6 * 2048 + h * 128 + vs * 32 + vv8;
    uint4 rq[2], rf[2], rv = {0, 0, 0, 0};
#define HG_PREFETCH(c) do { _Pragma("unroll") for (int ps = 0; ps < 2; ++ps) { const size_t t = (size_t)(c) * 64 + pt + 32 * ps; rq[ps] = *(const uint4*)(qbase + t * NPROJ); rf[ps] = *(const uint4*)(fbase + t * NPROJ); } \
        if (tid < 256) rv = *(const uint4*)(vbase + (size_t)((c) * 64 + vt) * NPROJ); } while (0)
    HG_PREFETCH(0);
    float S[8];
#pragma unroll
    for (int j = 0; j < 8; ++j) S[j] = 0.f;
    for (int c = 0; c < 32; ++c) {
#pragma unroll
        for (int ps = 0; ps < 2; ++ps) { const int t = pt + 32 * ps; float q[8], f[8]; unpack8(rq[ps], q); unpack8(rf[ps], f);
#pragma unroll
            for (int j = 0; j < 8; ++j) { q[j] = silu(q[j]) * QSCALE; f[j] = lbv[j] + (1.0f - lbv[j]) * sigm(f[j]); }
            *(float4*)&Q[t * 128 + pk] = make_float4(q[0], q[1], q[2], q[3]); *(float4*)&Q[t * 128 + pk + 4] = make_float4(q[4], q[5], q[6], q[7]);
            *(float4*)&F[t * 128 + pk] = make_float4(f[0], f[1], f[2], f[3]); *(float4*)&F[t * 128 + pk + 4] = make_float4(f[4], f[5], f[6], f[7]); }
        if (tid < 256) { float v[8]; unpack8(rv, v); *(float4*)&V[vt * 32 + vv8] = make_float4(v[0], v[1], v[2], v[3]); *(float4*)&V[vt * 32 + vv8 + 4] = make_float4(v[4], v[5], v[6], v[7]); }
        if (c + 1 < 32) HG_PREFETCH(c + 1);
        lds_barrier();
#pragma unroll 4
        for (int t = 0; t < 64; ++t) {
            const float4 fa = *(const float4*)&F[t * 128 + kg * 4], fb = *(const float4*)&F[t * 128 + 64 + kg * 4];
            const float4 qa = *(const float4*)&Q[t * 128 + kg * 4], qb = *(const float4*)&Q[t * 128 + 64 + kg * 4];
            const float vv = V[t * 32 + vcol];
            float acc;
            S[0] = fa.x * (S[0] - vv) + vv; acc = S[0] * qa.x;
            S[1] = fa.y * (S[1] - vv) + vv; acc += S[1] * qa.y;
            S[2] = fa.z * (S[2] - vv) + vv; acc += S[2] * qa.z;
            S[3] = fa.w * (S[3] - vv) + vv; acc += S[3] * qa.w;
            S[4] = fb.x * (S[4] - vv) + vv; acc += S[4] * qb.x;
            S[5] = fb.y * (S[5] - vv) + vv; acc += S[5] * qb.y;
            S[6] = fb.z * (S[6] - vv) + vv; acc += S[6] * qb.z;
            S[7] = fb.w * (S[7] - vv) + vv; acc += S[7] * qb.w;
            acc = row16_sum(acc);
            if (kg == 0) O[t * 32 + vcol] = acc;
        }
        lds_barrier();
        { const int t = tid >> 3, v4 = (tid & 7) * 4; *(float4*)&ows[(row0 + c * 64 + t) * DM + h * 128 + vs * 32 + v4] = *(const float4*)&O[t * 32 + v4]; }
    }
#undef HG_PREFETCH
    float* Sl = Q;
#pragma unroll
    for (int j = 0; j < 4; ++j) { Sl[(kg * 4 + j) * 32 + vcol] = S[j]; Sl[(64 + kg * 4 + j) * 32 + vcol] = S[4 + j]; }
    lds_barrier();
    { const int k = tid >> 2, v8 = (tid & 3) * 8; float* d = p.out + OFF_NHP + ((size_t)((b * 16 + h) * 128 + k)) * 128 + vs * 32 + v8;
      *(float4*)d = *(const float4*)&Sl[k * 32 + v8]; *(float4*)(d + 4) = *(const float4*)&Sl[k * 32 + v8 + 4]; }
    lds_barrier();
}

__device__ void hgrn_sample_item(const Params& p, unsigned char* lds, int it) {
    const int h = it & 15, b = it >> 4;
    float* Q = (float*)lds; float* F = Q + 1024; float* Op = F + 1024;
    const int tid = threadIdx.x, lane = tid & 63, w = tid >> 6;
    const bf16_t* proj = (const bf16_t*)(p.ws + WS_PROJ);
    float* ows = (float*)(p.ws + WS_O);
    const size_t soff = (size_t)it * 16384 + (size_t)(16 * w) * 128 + 2 * lane;
    const float* s0 = p.state_hgrn + soff;
    float2 S[16];
#pragma unroll
    for (int j = 0; j < 16; ++j) S[j] = *(const float2*)(s0 + j * 128);
    const size_t row0 = (size_t)PROWS + (size_t)b * 8;
    float2 vv[8];
#pragma unroll
    for (int t = 0; t < 8; ++t) { const unsigned u = *(const unsigned*)(proj + (row0 + t) * NPROJ + 6 * 2048 + h * 128 + 2 * lane); vv[t] = make_float2(bflo(u), bfhi(u)); }
    if (tid < 128) { const int t = tid >> 4, pk = (tid & 15) * 8;
        const float* l0 = p.lb_logits + h * 128 + pk; const float* l1 = l0 + 2048;
        const bf16_t* qp = proj + (row0 + t) * NPROJ + 4 * 2048 + h * 128 + pk;
        const uint4 rq = *(const uint4*)qp, rf = *(const uint4*)(qp + 2048);
        float q[8], f[8]; unpack8(rq, q); unpack8(rf, f);
#pragma unroll
        for (int j = 0; j < 8; ++j) { const float lb = 1.0f / (1.0f + __expf(l1[j] - l0[j])); q[j] = silu(q[j]) * QSCALE; f[j] = lb + (1.0f - lb) * sigm(f[j]); }
        *(float4*)&Q[t * 128 + pk] = make_float4(q[0], q[1], q[2], q[3]); *(float4*)&Q[t * 128 + pk + 4] = make_float4(q[4], q[5], q[6], q[7]);
        *(float4*)&F[t * 128 + pk] = make_float4(f[0], f[1], f[2], f[3]); *(float4*)&F[t * 128 + pk + 4] = make_float4(f[4], f[5], f[6], f[7]); }
    lds_barrier();
#pragma unroll
    for (int t = 0; t < 8; ++t) { float2 op = make_float2(0.f, 0.f);
#pragma unroll
        for (int j4 = 0; j4 < 4; ++j4) { const float4 f4 = *(const float4*)&F[t * 128 + 16 * w + j4 * 4], q4 = *(const float4*)&Q[t * 128 + 16 * w + j4 * 4];
            const float ff[4] = {f4.x, f4.y, f4.z, f4.w}, qq[4] = {q4.x, q4.y, q4.z, q4.w};
#pragma unroll
            for (int j = 0; j < 4; ++j) { float2& s = S[j4 * 4 + j]; s.x = ff[j] * (s.x - vv[t].x) + vv[t].x; s.y = ff[j] * (s.y - vv[t].y) + vv[t].y; op.x += s.x * qq[j]; op.y += s.y * qq[j]; } }
        *(float2*)&Op[(w * 8 + t) * 128 + 2 * lane] = op; }
    float* d = p.out + OFF_NHS + soff;
#pragma unroll
    for (int j = 0; j < 16; ++j) *(float2*)(d + j * 128) = S[j];
    lds_barrier();
    { const int idx = tid * 2, t = idx >> 7, v = idx & 127; float2 s = make_float2(0.f, 0.f);
#pragma unroll
      for (int ww = 0; ww < 8; ++ww) { const float2 o = *(const float2*)&Op[(ww * 8 + t) * 128 + v]; s.x += o.x; s.y += o.y; }
      *(float2*)&ows[(row0 + t) * DM + h * 128 + v] = s; }
    lds_barrier();
}

__device__ void conv_item(const Params& p, int item) {
    const int tid = threadIdx.x, half = tid >> 8, c0 = (tid & 255) * 8;
    const bf16_t* proj = (const bf16_t*)(p.ws + WS_PROJ);
    bf16_t* mix = (bf16_t*)(p.ws + WS_MIX);
    size_t row0; int t0, L, T; float* ncout; bool sample;
    if (item < 256) { const int g = item * 2 + half; row0 = (size_t)g * 16; const int b = g >> 7; t0 = (g & 127) * 16; L = 16; T = 2048; ncout = p.out + OFF_NCP + (size_t)b * 2 * 2048; sample = false; }
    else { const int s = (item - 256) * 2 + half; row0 = (size_t)PROWS + (size_t)s * 8; t0 = 0; L = 8; T = 8; ncout = p.out + OFF_NCS + (size_t)s * 2 * 2048; sample = true; }
    float w0[8], w1[8], w2[8], na[8], u1[8], u2[8];
    { const float4 a = *(const float4*)(p.conv_w + c0), b = *(const float4*)(p.conv_w + c0 + 4); w0[0] = a.x; w0[1] = a.y; w0[2] = a.z; w0[3] = a.w; w0[4] = b.x; w0[5] = b.y; w0[6] = b.z; w0[7] = b.w; }
    { const float4 a = *(const float4*)(p.conv_w + 2048 + c0), b = *(const float4*)(p.conv_w + 2048 + c0 + 4); w1[0] = a.x; w1[1] = a.y; w1[2] = a.z; w1[3] = a.w; w1[4] = b.x; w1[5] = b.y; w1[6] = b.z; w1[7] = b.w; }
    { const float4 a = *(const float4*)(p.conv_w + 4096 + c0), b = *(const float4*)(p.conv_w + 4096 + c0 + 4); w2[0] = a.x; w2[1] = a.y; w2[2] = a.z; w2[3] = a.w; w2[4] = b.x; w2[5] = b.y; w2[6] = b.z; w2[7] = b.w; }
    { const float4 a = *(const float4*)(p.norm_a + c0), b = *(const float4*)(p.norm_a + c0 + 4); na[0] = a.x; na[1] = a.y; na[2] = a.z; na[3] = a.w; na[4] = b.x; na[5] = b.y; na[6] = b.z; na[7] = b.w; }
    if (sample) { const float* sc = p.state_conv + (size_t)((item - 256) * 2 + half) * 2 * 2048 + c0;
        const float4 a = *(const float4*)sc, b = *(const float4*)(sc + 4), c = *(const float4*)(sc + 2048), d = *(const float4*)(sc + 2048 + 4);
        u2[0] = a.x; u2[1] = a.y; u2[2] = a.z; u2[3] = a.w; u2[4] = b.x; u2[5] = b.y; u2[6] = b.z; u2[7] = b.w;
        u1[0] = c.x; u1[1] = c.y; u1[2] = c.z; u1[3] = c.w; u1[4] = d.x; u1[5] = d.y; u1[6] = d.z; u1[7] = d.w; }
    else if (t0 == 0) {
#pragma unroll
        for (int j = 0; j < 8; ++j) { u1[j] = 0.f; u2[j] = 0.f; } }
    else { const bf16_t* r2 = proj + (row0 - 2) * NPROJ + c0; const bf16_t* r1 = r2 + NPROJ;
        const uint4 v2 = *(const uint4*)r2, cc2 = *(const uint4*)(r2 + 2 * 2048), v1 = *(const uint4*)r1, cc1 = *(const uint4*)(r1 + 2 * 2048);
        float a[8], b[8]; unpack8(v2, a); unpack8(cc2, b);
#pragma unroll
        for (int j = 0; j < 8; ++j) u2[j] = a[j] * b[j];
        unpack8(v1, a); unpack8(cc1, b);
#pragma unroll
        for (int j = 0; j < 8; ++j) u1[j] = a[j] * b[j]; }
    for (int tb = 0; tb < L; tb += 4) {
        uint4 rv[4], rb[4], rc[4], rz[4];
#pragma unroll
        for (int i = 0; i < 4; ++i) { const bf16_t* r = proj + (row0 + tb + i) * NPROJ + c0; rv[i] = *(const uint4*)r; rb[i] = *(const uint4*)(r + 2048); rc[i] = *(const uint4*)(r + 4096); rz[i] = *(const uint4*)(r + 6144); }
#pragma unroll
        for (int i = 0; i < 4; ++i) {
            float v[8], bb[8], cc[8], z[8], u[8], pre[8]; unpack8(rv[i], v); unpack8(rb[i], bb); unpack8(rc[i], cc); unpack8(rz[i], z);
            float ss = 0.f;
#pragma unroll
            for (int j = 0; j < 8; ++j) { u[j] = cc[j] * v[j]; const float cv = w0[j] * u2[j] + w1[j] * u1[j] + w2[j] * u[j]; pre[j] = bb[j] * cv; ss += pre[j] * pre[j]; }
            ss = row16_sum(ss);
            const float sc = rsqrtf(ss * (1.0f / 128.0f) + EPSV);
            float y[8];
#pragma unroll
            for (int j = 0; j < 8; ++j) { y[j] = pre[j] * sc * na[j] * silu(z[j]); u2[j] = u1[j]; u1[j] = u[j]; }
            *(uint4*)(mix + (row0 + tb + i) * DMIX + c0) = pack8(y);
            const int t = t0 + tb + i;
            if (t >= T - 2) { float* d = ncout + (size_t)(t - (T - 2)) * 2048 + c0; *(float4*)d = make_float4(u[0], u[1], u[2], u[3]); *(float4*)(d + 4) = make_float4(u[4], u[5], u[6], u[7]); }
        }
    }
}

__device__ void phase2(const Params& p, unsigned char* lds) {
    for (int it = blockIdx.x; it < 256; it += gridDim.x) hgrn_prompt_item(p, lds, it);
    for (int it = blockIdx.x; it < 2048; it += gridDim.x) hgrn_sample_item(p, lds, it);
    for (int it = blockIdx.x; it < 320; it += gridDim.x) conv_item(p, it);
}

__device__ void phase3(const Params& p) {
    const int tid = threadIdx.x, half = tid >> 8, c0 = (tid & 255) * 8;
    const bf16_t* proj = (const bf16_t*)(p.ws + WS_PROJ);
    const float* ows = (const float*)(p.ws + WS_O);
    bf16_t* mix = (bf16_t*)(p.ws + WS_MIX);
    float nb[8];
    { const float4 a = *(const float4*)(p.norm_b + c0), b = *(const float4*)(p.norm_b + c0 + 4); nb[0] = a.x; nb[1] = a.y; nb[2] = a.z; nb[3] = a.w; nb[4] = b.x; nb[5] = b.y; nb[6] = b.z; nb[7] = b.w; }
    for (int base = blockIdx.x * 8; base < MROWS; base += gridDim.x * 8) {
        float4 oa[4], ob[4]; uint4 rz[4];
#pragma unroll
        for (int i = 0; i < 4; ++i) { const size_t r = (size_t)base + half * 4 + i; oa[i] = *(const float4*)(ows + r * DM + c0); ob[i] = *(const float4*)(ows + r * DM + c0 + 4); rz[i] = *(const uint4*)(proj + r * NPROJ + 7 * 2048 + c0); }
#pragma unroll
        for (int i = 0; i < 4; ++i) { const size_t r = (size_t)base + half * 4 + i;
            const float o[8] = {oa[i].x, oa[i].y, oa[i].z, oa[i].w, ob[i].x, ob[i].y, ob[i].z, ob[i].w}; float z[8]; unpack8(rz[i], z);
            float ss = 0.f;
#pragma unroll
            for (int j = 0; j < 8; ++j) ss += o[j] * o[j];
            ss = row16_sum(ss);
            const float sc = rsqrtf(ss * (1.0f / 128.0f) + EPSV);
            float y[8];
#pragma unroll
            for (int j = 0; j < 8; ++j) y[j] = o[j] * sc * nb[j] * silu(z[j]);
            *(uint4*)(mix + r * DMIX + 2048 + c0) = pack8(y); }
    }
}

__device__ void phase5(const Params& p) {
    const int tid = threadIdx.x, lane = tid & 63, w = tid >> 6;
    const float* hws = (const float*)(p.ws + WS_H);
    for (int row = blockIdx.x * 8 + w; row < MROWS; row += gridDim.x * 8) {
        const float* xr = row < PROWS ? p.x_prompt + (size_t)row * DM : p.x_sample + (size_t)(row - PROWS) * DM;
        const float* hr = hws + (size_t)row * DM;
        float4 r[8]; float s = 0.f;
#pragma unroll
        for (int i = 0; i < 8; ++i) { const int col = i * 256 + lane * 4; const float4 x4 = *(const float4*)(xr + col), h4 = *(const float4*)(hr + col);
            r[i] = make_float4(ALPHA * x4.x + h4.x, ALPHA * x4.y + h4.y, ALPHA * x4.z + h4.z, ALPHA * x4.w + h4.w); s += (r[i].x + r[i].y) + (r[i].z + r[i].w); }
#pragma unroll
        for (int o = 32; o > 0; o >>= 1) s += __shfl_xor(s, o);
        const float mu = s * (1.0f / 2048.0f); float q = 0.f;
#pragma unroll
        for (int i = 0; i < 8; ++i) { r[i].x -= mu; r[i].y -= mu; r[i].z -= mu; r[i].w -= mu; q += (r[i].x * r[i].x + r[i].y * r[i].y) + (r[i].z * r[i].z + r[i].w * r[i].w); }
#pragma unroll
        for (int o = 32; o > 0; o >>= 1) q += __shfl_xor(q, o);
        const float rs = rsqrtf(q * (1.0f / 2048.0f) + EPSV);
        float* yr = p.out + OFF_Y + (size_t)row * DM;
#pragma unroll
        for (int i = 0; i < 8; ++i) { const int col = i * 256 + lane * 4; const float4 g = *(const float4*)(p.ln_gain + col), bb = *(const float4*)(p.ln_bias + col);
            *(float4*)(yr + col) = make_float4(r[i].x * rs * g.x + bb.x, r[i].y * rs * g.y + bb.y, r[i].z * rs * g.z + bb.z, r[i].w * rs * g.w + bb.w); }
    }
}

__global__ __launch_bounds__(512, 2) void mega(Params p) {
    extern __shared__ __attribute__((aligned(16))) unsigned char shm[];
    cg::grid_group grid = cg::this_grid();
#define RUN_PHASE(i, ...) if (p.ph_lo <= (i) && (i) < p.ph_hi) { if ((i) > p.ph_lo) grid.sync(); __VA_ARGS__ }
    RUN_PHASE(0, phase0(p, shm);)
    RUN_PHASE(1, { pg8::Gemm g{(const bf16_t*)(p.ws + WS_A1), (const bf16_t*)(p.ws + WS_BT1), MROWS, NPROJ, DM};
        pg8::StaticOrder S; S.init(MROWS, NPROJ, (int)gridDim.x, (int)blockIdx.x);
        pg8::EpiBf16<0> E{(bf16_t*)(p.ws + WS_PROJ), NPROJ, nullptr, 0, 0};
        pg8::gemm_phase<pg8::EpiBf16<0>, pg8::StaticOrder, false>((PG8_LAS unsigned char*)shm, g, S, E, nullptr); })
    RUN_PHASE(2, phase2(p, shm);)
    RUN_PHASE(3, phase3(p);)
    RUN_PHASE(4, { pg8::Gemm g{(const bf16_t*)(p.ws + WS_MIX), (const bf16_t*)(p.ws + WS_BT2), MROWS, DM, DMIX};
        pg8::StaticOrder S; S.init(MROWS, DM, (int)gridDim.x, (int)blockIdx.x);
        pg8::EpiF32 E{(float*)(p.ws + WS_H), DM, nullptr};
        pg8::gemm_phase<pg8::EpiF32, pg8::StaticOrder, false>((PG8_LAS unsigned char*)shm, g, S, E, nullptr); })
    RUN_PHASE(5, phase5(p);)
#undef RUN_PHASE
}

#ifndef N_LAUNCHES
#define N_LAUNCHES 6
#endif
extern "C" void kernel_launch(void* const* d_in, const int* in_sizes, int n_in, void* d_out, int out_size, void* d_ws, size_t ws_size, hipStream_t stream) {
    static int grid = 0;
    if (grid == 0) {
        if (n_in != 12 || ws_size < WS_END) { fprintf(stderr, "kernel_launch: unexpected shapes (n_in %d, ws %zu < %zu)\n", n_in, ws_size, (size_t)WS_END); grid = -1; return; }
        int dev = 0, cus = 0, per_cu = 0;
        hipGetDevice(&dev); hipDeviceGetAttribute(&cus, hipDeviceAttributeMultiprocessorCount, dev);
        if (hipFuncSetAttribute((const void*)mega, hipFuncAttributeMaxDynamicSharedMemorySize, LDS_BYTES) != hipSuccess) { fprintf(stderr, "kernel_launch: hipFuncSetAttribute failed\n"); grid = -1; return; }
        if (hipOccupancyMaxActiveBlocksPerMultiprocessor(&per_cu, (const void*)mega, 512, LDS_BYTES) != hipSuccess || per_cu < 1) { fprintf(stderr, "kernel_launch: occupancy query says %d\n", per_cu); per_cu = 1; }
        (void)hipGetLastError();
        grid = cus * 1;
        if (grid <= 0) grid = 256;
    }
    if (grid < 0) return;
    Params p{};
    p.x_prompt = (const float*)d_in[0]; p.x_sample = (const float*)d_in[1]; p.state_conv = (const float*)d_in[2]; p.state_hgrn = (const float*)d_in[3];
    p.w_in = (const float*)d_in[4]; p.conv_w = (const float*)d_in[5]; p.norm_a = (const float*)d_in[6]; p.lb_logits = (const float*)d_in[7]; p.norm_b = (const float*)d_in[8];
    p.w_out = (const float*)d_in[9]; p.ln_gain = (const float*)d_in[10]; p.ln_bias = (const float*)d_in[11];
    p.out = (float*)d_out; p.ws = (unsigned char*)d_ws;
#if N_LAUNCHES == 1
    p.ph_lo = 0; p.ph_hi = 6;
    void* args[] = {&p};
    hipError_t e = hipLaunchCooperativeKernel((const void*)mega, dim3(grid), dim3(512), args, LDS_BYTES, stream);
    if (e != hipSuccess) fprintf(stderr, "cooperative launch failed: %s (grid %d)\n", hipGetErrorString(e), grid);
#else
    for (int i = 0; i < 6; ++i) { p.ph_lo = i; p.ph_hi = i + 1; hipLaunchKernelGGL(mega, dim3(grid), dim3(512), LDS_BYTES, stream, p); }
#endif
}
```

```cpp
#include <hip/hip_runtime.h>
namespace pg8 {
#define PG8_LAS __attribute__((address_space(3)))
typedef unsigned short bf16_t;
typedef short bf16x8 __attribute__((ext_vector_type(8)));
typedef float f32x4 __attribute__((ext_vector_type(4)));
typedef unsigned u32x4 __attribute__((ext_vector_type(4)));
constexpr int BM = 256, BK = 64, HALF = 128, HTB = HALF * BK * 2  , STAGE_BYTES = 8 * HTB, NXCD = 8, WGM = 8;

__host__ __device__ __forceinline__ int lds_byte(int r, int c) { const int st = (r >> 4) * 2 + (c >> 5), rr = r & 15, cc = c & 31, ob = rr * 64 + cc * 2; return st * 1024 + (ob ^ (((ob >> 9) & 1) << 5)); }
__host__ __device__ __forceinline__ void stage_rc(int b, int& R, int& C) { const int st = b / 1024, sb = b % 1024, swz = sb ^ (((sb >> 9) & 1) << 5); R = (st >> 1) * 16 + swz / 64; C = (st & 1) * 32 + (swz % 64) / 2; }
__host__ __device__ __forceinline__ int perm32(int rho) { const int n = rho >> 4, i = rho & 15; return 8 * (i >> 2) + 4 * n + (i & 3); }

struct Unit { int pm, pn; };
struct Gemm { const bf16_t* A; const bf16_t* Bt; int M, N, K, ld; };

struct StaticOrder {
    int nM, nN, nwg, G, c;
    __host__ __device__ void init(int M, int N, int G_, int c_) { nM = M / BM; nN = N / BM; nwg = nM * nN; G = G_; c = c_; }
    __host__ __device__ bool next(int i, Unit& u) const {
        const long L = (long)i * G + c; if (L >= nwg) return false;
        int wgid = (int)L; { const int q = nwg / NXCD, r = nwg % NXCD, xcd = wgid % NXCD, off = wgid / NXCD; wgid = (xcd < r ? xcd * (q + 1) : r * (q + 1) + (xcd - r) * q) + off; }
        const int nig = WGM * nN, gid = wgid / nig, fm = gid * WGM, gsz = (nM - fm) < WGM ? (nM - fm) : WGM;
        u.pm = fm + ((wgid % nig) % gsz); u.pn = (wgid % nig) / gsz; return true;
    }
    __device__ __forceinline__ void a_ready(const Unit&) const {}
    __device__ __forceinline__ void done(const Unit&) const {}
};
__device__ __forceinline__ unsigned cvt_pk_bf16(float lo, float hi) { unsigned r; asm volatile("v_cvt_pk_bf16_f32 %0, %1, %2" : "=v"(r) : "v"(lo), "v"(hi)); return r; }
typedef float f32x2 __attribute__((ext_vector_type(2)));
__device__ __forceinline__ f32x2 gelu_pk(f32x2 v) {
    const f32x2 av = __builtin_elementwise_abs(v), d = av * 0.2316418882f + 1.0f;
    f32x2 t; t.x = __builtin_amdgcn_rcpf(d.x); t.y = __builtin_amdgcn_rcpf(d.y);
    f32x2 q = t * 0.5307027145f + (-0.7265760135f); q = q * t + 0.7107068705f; q = q * t + (-0.142248368f); q = q * t + 0.127414796f; q = q * t;
    const f32x2 s = (v * v) * (-0.72134752044f);
    f32x2 e; e.x = __builtin_amdgcn_exp2f(s.x); e.y = __builtin_amdgcn_exp2f(s.y);
    const f32x2 m = v * (q * e), r = v - m;
    f32x2 o; o.x = v.x < 0.f ? m.x : r.x; o.y = v.y < 0.f ? m.y : r.y; return o;
}

struct EpiF32 {
    static constexpr bool PERM = false, AFTER_DRAIN = false;
    float* C; int ldc; const float* bias;
    __device__ __forceinline__ void operator()(const f32x4 (&acc)[2][2][4][2], const Unit& u, int wr, int wc, int fr, int fq) const {
        const int row0 = u.pm * BM + wr * 64 + fr, col0 = u.pn * BM + wc * 32 + 4 * fq;
        f32x4 bv[2][2];
#pragma unroll
        for (int bj = 0; bj < 2; ++bj)
#pragma unroll
            for (int n = 0; n < 2; ++n) bv[bj][n] = bias ? *(const f32x4*)(bias + col0 + bj * HALF + n * 16) : (f32x4){0.f, 0.f, 0.f, 0.f};
#pragma unroll
        for (int ai = 0; ai < 2; ++ai)
#pragma unroll
            for (int m = 0; m < 4; ++m) { float* rowp = C + (size_t)(row0 + ai * HALF + m * 16) * ldc + col0;
#pragma unroll
                for (int bj = 0; bj < 2; ++bj)
#pragma unroll
                    for (int n = 0; n < 2; ++n) *(f32x4*)(rowp + bj * HALF + n * 16) = acc[ai][bj][m][n] + bv[bj][n]; }
    }
};
template <int ACT  > struct EpiBf16 {
    static constexpr bool PERM = true, AFTER_DRAIN = false;
    bf16_t* O; int ldc; const float* bias; int split_cols; size_t split_stride;
    __device__ __forceinline__ void operator()(const f32x4 (&acc)[2][2][4][2], const Unit& u, int wr, int wc, int fr, int fq) const {
        const int row0 = u.pm * BM + wr * 64 + fr; int colt = u.pn * BM; bf16_t* base = O;
        if (split_cols) { const int t = colt / split_cols; base += (size_t)t * split_stride; colt -= t * split_cols; }
        const int col0 = colt + wc * 32 + 8 * fq, bcol0 = u.pn * BM + wc * 32 + 8 * fq;
        f32x4 bv[2][2];
#pragma unroll
        for (int bj = 0; bj < 2; ++bj)
#pragma unroll
            for (int n = 0; n < 2; ++n) bv[bj][n] = bias ? *(const f32x4*)(bias + bcol0 + bj * HALF + 4 * n) : (f32x4){0.f, 0.f, 0.f, 0.f};
#pragma unroll
        for (int ai = 0; ai < 2; ++ai)
#pragma unroll
            for (int m = 0; m < 4; ++m) { bf16_t* rowp = base + (size_t)(row0 + ai * HALF + m * 16) * ldc + col0;
#pragma unroll
                for (int bj = 0; bj < 2; ++bj) { f32x4 v0 = acc[ai][bj][m][0] + bv[bj][0], v1 = acc[ai][bj][m][1] + bv[bj][1];
                    if (ACT == 1) { f32x2 a = gelu_pk((f32x2){v0[0], v0[1]}), b = gelu_pk((f32x2){v0[2], v0[3]}), c = gelu_pk((f32x2){v1[0], v1[1]}), d = gelu_pk((f32x2){v1[2], v1[3]});
                        v0 = (f32x4){a.x, a.y, b.x, b.y}; v1 = (f32x4){c.x, c.y, d.x, d.y}; }
                    if (ACT == 2) {
#pragma unroll
                        for (int j = 0; j < 4; ++j) { v0[j] = 0.5f * v0[j] * (1.0f + erff(v0[j] * 0.70710678f)); v1[j] = 0.5f * v1[j] * (1.0f + erff(v1[j] * 0.70710678f)); } }
                    u32x4 w; w.x = cvt_pk_bf16(v0[0], v0[1]); w.y = cvt_pk_bf16(v0[2], v0[3]); w.z = cvt_pk_bf16(v1[0], v1[1]); w.w = cvt_pk_bf16(v1[2], v1[3]);
                    *(u32x4*)(rowp + bj * HALF) = w; } }
    }
};

template <class Epi, class Sched, bool STAMP = false>
__device__ __forceinline__ void gemm_phase(PG8_LAS unsigned char* lds, const Gemm g, const Sched& S, const Epi& E, unsigned long long* stamps) {
    const int tid = threadIdx.x, wid = __builtin_amdgcn_readfirstlane(tid >> 6), lane = tid & 63, wr = wid >> 2, wc = wid & 3, fr = lane & 15, fq = lane >> 4;
    const int K = g.ld, nt = g.K / BK;
    int ts_lo = 0, ts_hi = 0, nts = 0; const unsigned long long rt_entry = STAMP ? (unsigned long long)wall_clock64() : 0ull;
#define PG8_STAMP() do { if (STAMP && wid == 0 && nts < 64) { const unsigned long long _c = (unsigned long long)clock64(); \
        ts_lo = (lane == nts) ? (int)(unsigned)_c : ts_lo; ts_hi = (lane == nts) ? (int)(unsigned)(_c >> 32) : ts_hi; ++nts; } } while (0)
    PG8_STAMP();
    unsigned voffA[2], voffB[2];
#pragma unroll
    for (int i = 0; i < 2; ++i) { int R, C; stage_rc(tid * 16 + i * 8192, R, C); const int Rb = Epi::PERM ? ((R & ~31) + perm32(R & 31)) : R;
        voffA[i] = (unsigned)(R * K + C) * 2u; voffB[i] = (unsigned)(Rb * K + C) * 2u; }
    const size_t kstep = (size_t)(BK * 2);
    const size_t hstep = (size_t)HALF * K * 2;
    const size_t tstep = 2 * hstep;
    const unsigned ldsw = (unsigned)wid * 1024u;
    const int aoff = lds_byte(wr * 64 + fr, fq * 8), boff = lds_byte(wc * 32 + fr, fq * 8);
#define PG8_SA(b, h) (((b) * 2 + (h)) * HTB)
#define PG8_SB(b, h) ((4 + (b) * 2 + (h)) * HTB)
#define PG8_STAGE(bufoff, gbase, voff) do { _Pragma("unroll") for (int _i = 0; _i < 2; ++_i) \
        __builtin_amdgcn_global_load_lds((const unsigned*)((const char*)(gbase) + (voff)[_i]), (PG8_LAS unsigned*)(lds + (bufoff) + ldsw + _i * 8192), 16, 0, 0); } while (0)
#define PG8_LDA(dst, b, h) do { _Pragma("unroll") for (int m = 0; m < 4; ++m) _Pragma("unroll") for (int k = 0; k < 2; ++k) dst[m][k] = *(const PG8_LAS bf16x8*)(lds + PG8_SA(b, h) + aoff + m * 2048 + k * 1024); } while (0)
#define PG8_LDB(dst, b, h) do { _Pragma("unroll") for (int n = 0; n < 2; ++n) _Pragma("unroll") for (int k = 0; k < 2; ++k) dst[n][k] = *(const PG8_LAS bf16x8*)(lds + PG8_SB(b, h) + boff + n * 2048 + k * 1024); } while (0)
#define PG8_MMA(ai, bj, At, Bt) do { __builtin_amdgcn_s_setprio(1); _Pragma("unroll") for (int m = 0; m < 4; ++m) _Pragma("unroll") for (int n = 0; n < 2; ++n) _Pragma("unroll") for (int k = 0; k < 2; ++k) \
        acc[ai][bj][m][n] = __builtin_amdgcn_mfma_f32_16x16x32_bf16(Bt[n][k], At[m][k], acc[ai][bj][m][n], 0, 0, 0); __builtin_amdgcn_s_setprio(0); } while (0)
#define PG8_WAIT_V(n) asm volatile("s_waitcnt vmcnt(" #n ")" ::: "memory")
#define PG8_WAIT_L(n) asm volatile("s_waitcnt lgkmcnt(" #n ")" ::: "memory")
#define PG8_BAR __builtin_amdgcn_s_barrier()
#define PG8_SCHED __builtin_amdgcn_sched_barrier(0)
    Unit cur, nxt; int ui = 0;
    if (!S.next(0, cur)) return;
    f32x4 acc[2][2][4][2];
#pragma unroll
    for (int a = 0; a < 2; ++a)
#pragma unroll
        for (int b = 0; b < 2; ++b)
#pragma unroll
            for (int m = 0; m < 4; ++m)
#pragma unroll
                for (int n = 0; n < 2; ++n) acc[a][b][m][n] = (f32x4){0.f, 0.f, 0.f, 0.f};
    bf16x8 At[4][2], B0[2][2], B1[2][2];
    const char* cA = (const char*)g.A + (size_t)cur.pm * tstep; const char* cB = (const char*)g.Bt + (size_t)cur.pn * tstep;
    S.a_ready(cur);
    PG8_STAGE(PG8_SB(0, 0), cB, voffB); PG8_STAGE(PG8_SA(0, 0), cA, voffA); PG8_STAGE(PG8_SB(0, 1), cB + hstep, voffB); PG8_STAGE(PG8_SA(0, 1), cA + hstep, voffA);
    if (wr == 1) PG8_BAR;
    PG8_WAIT_V(4); PG8_BAR;
    PG8_STAGE(PG8_SB(1, 0), cB + kstep, voffB); PG8_STAGE(PG8_SA(1, 0), cA + kstep, voffA); PG8_STAGE(PG8_SB(1, 1), cB + hstep + kstep, voffB);
    PG8_WAIT_V(6); PG8_BAR;
    PG8_STAMP();
    for (;;) {
        const bool has_next = S.next(ui + 1, nxt);
        const char* nA = has_next ? (const char*)g.A + (size_t)nxt.pm * tstep : cA; const char* nB = has_next ? (const char*)g.Bt + (size_t)nxt.pn * tstep : cB;
        for (int t = 0; t < nt; t += 2) {
            const bool last = (t == nt - 2);
            const char* a1 = cA + (size_t)(t + 1) * kstep;
            const char* a2 = last ? nA : cA + (size_t)(t + 2) * kstep; const char* b2 = last ? nB : cB + (size_t)(t + 2) * kstep;
            const char* a3 = a2 + kstep; const char* b3 = b2 + kstep;
            if (last && has_next) S.a_ready(nxt);
            PG8_LDB(B0, 0, 0); PG8_SCHED; PG8_LDA(At, 0, 0); PG8_STAGE(PG8_SA(1, 1), a1 + hstep, voffA);
            PG8_WAIT_L(8); PG8_BAR; PG8_WAIT_L(0); PG8_MMA(0, 0, At, B0); PG8_BAR; PG8_SCHED;
            PG8_LDB(B1, 0, 1); PG8_STAGE(PG8_SB(0, 0), b2, voffB);
            PG8_BAR; PG8_WAIT_L(0); PG8_MMA(0, 1, At, B1); PG8_BAR;
            PG8_LDA(At, 0, 1); PG8_STAGE(PG8_SA(0, 0), a2, voffA);
            PG8_BAR; PG8_WAIT_L(0); PG8_MMA(1, 0, At, B0); PG8_BAR; PG8_SCHED;
            PG8_STAGE(PG8_SB(0, 1), b2 + hstep, voffB);
            PG8_WAIT_V(6); PG8_BAR; PG8_MMA(1, 1, At, B1); PG8_BAR;
            PG8_LDB(B0, 1, 0); PG8_SCHED; PG8_LDA(At, 1, 0); PG8_STAGE(PG8_SA(0, 1), a2 + hstep, voffA);
            PG8_WAIT_L(8); PG8_BAR; PG8_WAIT_L(0); PG8_MMA(0, 0, At, B0); PG8_BAR; PG8_SCHED;
            PG8_LDB(B1, 1, 1); PG8_STAGE(PG8_SB(1, 0), b3, voffB);
            PG8_BAR; PG8_WAIT_L(0); PG8_MMA(0, 1, At, B1); PG8_BAR;
            PG8_LDA(At, 1, 1); PG8_STAGE(PG8_SA(1, 0), a3, voffA);
            PG8_BAR; PG8_WAIT_L(0); PG8_MMA(1, 0, At, B0); PG8_BAR; PG8_SCHED;
            PG8_STAGE(PG8_SB(1, 1), b3 + hstep, voffB);
            PG8_WAIT_V(6); PG8_BAR; PG8_MMA(1, 1, At, B1); PG8_BAR;
        }
        PG8_STAMP();
        if constexpr (!Epi::AFTER_DRAIN) { E(acc, cur, wr, wc, fr, fq); S.done(cur); }
        PG8_STAMP();
        if (!has_next) break;
#pragma unroll
        for (int a = 0; a < 2; ++a)
#pragma unroll
            for (int b = 0; b < 2; ++b)
#pragma unroll
                for (int m = 0; m < 4; ++m)
#pragma unroll
                    for (int n = 0; n < 2; ++n) acc[a][b][m][n] = (f32x4){0.f, 0.f, 0.f, 0.f};
        cur = nxt; cA = nA; cB = nB; ++ui;
    }
    PG8_WAIT_V(0);
    if (wr == 0) PG8_BAR;
    PG8_BAR;
    if constexpr (Epi::AFTER_DRAIN) { E.fused(acc, cur, wr, wc, fr, fq, lds, wid, lane); S.done(cur); }
    PG8_STAMP();
    if (STAMP && wid == 0) { stamps[lane] = lane < nts ? (((unsigned long long)(unsigned)ts_hi << 32) | (unsigned)ts_lo) : 0ull;
        if (lane == 62) stamps[62] = rt_entry; if (lane == 63) stamps[63] = (unsigned long long)wall_clock64(); }
#undef PG8_STAMP
#undef PG8_SA
#undef PG8_SB
#undef PG8_STAGE
#undef PG8_LDA
#undef PG8_LDB
#undef PG8_MMA
#undef PG8_WAIT_V
#undef PG8_WAIT_L
#undef PG8_BAR
#undef PG8_SCHED
}
}

#include <cstdio>
#include <ctime>
#include <cstdlib>
#include <cstring>
#include <cmath>
#include <vector>
#include <algorithm>
#define CK(x) do { hipError_t e_ = (x); if (e_ != hipSuccess) { fprintf(stderr, "HIP %s:%d %s\n", __FILE__, __LINE__, hipGetErrorString(e_)); exit(2); } } while (0)
#include <hip/hip_cooperative_groups.h>
#include <cstdio>
namespace cg = cooperative_groups;
using pg8::bf16_t;
typedef float f32x2_t __attribute__((ext_vector_type(2)));
typedef __bf16 bf16x2_t __attribute__((ext_vector_type(2)));
__device__ __forceinline__ unsigned pkbf(float lo, float hi) { const f32x2_t v = {lo, hi}; const bf16x2_t r = __builtin_convertvector(v, bf16x2_t); return __builtin_bit_cast(unsigned, r); }

constexpr int DM = 2048, NPROJ = 16384, DMIX = 4096;
constexpr int PROWS = 8192, SROWS = 1024, MROWS = 9216;
constexpr int LDS_STAGE = 131072, LDS_BYTES = LDS_STAGE + 64;
constexpr float EPSV = 1e-5f;
constexpr float ALPHA = 1.189207115002721f;
constexpr float QSCALE = 0.08838834764831845f;

constexpr size_t WS_A1 = 0;
constexpr size_t WS_BT1 = WS_A1 + (size_t)MROWS * DM * 2;
constexpr size_t WS_O = 0;
constexpr size_t WS_BT2 = WS_BT1 + (size_t)NPROJ * DM * 2;
constexpr size_t WS_PROJ = WS_BT2 + (size_t)DM * DMIX * 2;
constexpr size_t WS_H = WS_PROJ;
constexpr size_t WS_HPART = WS_H + (size_t)MROWS * DM * 4;
constexpr size_t WS_MIX = WS_PROJ + (size_t)MROWS * NPROJ * 2;
constexpr size_t WS_CTR = WS_MIX + (size_t)MROWS * DMIX * 2;
constexpr size_t WS_BAR = WS_CTR + 256;
constexpr size_t WS_END = WS_BAR + 3456 * 4;

constexpr size_t OFF_Y = 0;
constexpr size_t OFF_NCP = (size_t)MROWS * DM;
constexpr size_t OFF_NHP = OFF_NCP + 4 * 2 * 2048;
constexpr size_t OFF_NCS = OFF_NHP + (size_t)4 * 16 * 128 * 128;
constexpr size_t OFF_NHS = OFF_NCS + (size_t)128 * 2 * 2048;

struct Params {
    const float* x_prompt; const float* x_sample; const float* state_conv; const float* state_hgrn;
    const float* w_in; const float* conv_w; const float* norm_a; const float* lb_logits; const float* norm_b;
    const float* w_out; const float* ln_gain; const float* ln_bias;
    float* out; unsigned char* ws;
    int ph_lo, ph_hi;
};

__device__ __forceinline__ float bflo(unsigned u) { return __uint_as_float(u << 16); }
__device__ __forceinline__ float bfhi(unsigned u) { return __uint_as_float(u & 0xffff0000u); }
__device__ __forceinline__ void unpack8(const uint4 r, float (&f)[8]) {
    f[0] = bflo(r.x); f[1] = bfhi(r.x); f[2] = bflo(r.y); f[3] = bfhi(r.y); f[4] = bflo(r.z); f[5] = bfhi(r.z); f[6] = bflo(r.w); f[7] = bfhi(r.w);
}
__device__ __forceinline__ uint4 pack8(const float (&f)[8]) {
    uint4 r; r.x = pkbf(f[0], f[1]); r.y = pkbf(f[2], f[3]); r.z = pkbf(f[4], f[5]); r.w = pkbf(f[6], f[7]); return r;
}
__device__ __forceinline__ uint4 ntl16(const void* p) { const pg8::u32x4 t = __builtin_nontemporal_load((const pg8::u32x4*)p); return make_uint4(t.x, t.y, t.z, t.w); }
__device__ __forceinline__ float sigm(float x) { return 1.0f / (1.0f + __expf(-x)); }
__device__ __forceinline__ float silu(float x) { return x / (1.0f + __expf(-x)); }
__device__ __forceinline__ void lds_barrier() { asm volatile("s_waitcnt lgkmcnt(0)" ::: "memory"); __builtin_amdgcn_s_barrier(); asm volatile("" ::: "memory"); }
#define DPP_ROR(x, n) __builtin_bit_cast(float, __builtin_amdgcn_update_dpp(0, __builtin_bit_cast(int, (x)), 0x120 + (n), 0xF, 0xF, true))
__device__ __forceinline__ float row16_sum(float x) { x += DPP_ROR(x, 8); x += DPP_ROR(x, 4); x += DPP_ROR(x, 2); x += DPP_ROR(x, 1); return x; }


typedef _Float16 h16x2 __attribute__((ext_vector_type(2)));
__device__ __forceinline__ unsigned pack_h2(float a, float b) { const h16x2 v = {(_Float16)a, (_Float16)b}; return __builtin_bit_cast(unsigned, v); }
__device__ __forceinline__ float h2lo(unsigned u) { return (float)__builtin_bit_cast(h16x2, u)[0]; }
__device__ __forceinline__ float h2hi(unsigned u) { return (float)__builtin_bit_cast(h16x2, u)[1]; }
__device__ __forceinline__ float ex2(float x) { return __builtin_amdgcn_exp2f(x); }

struct EpiProj {
    static constexpr bool PERM = true, AFTER_DRAIN = false;
    bf16_t* O; const float* lbl;
    __device__ __forceinline__ void operator()(const pg8::f32x4 (&acc)[2][2][4][2], const pg8::Unit& u, int wr, int wc, int fr, int fq) const {
        using namespace pg8;
        const int row0 = u.pm * BM + wr * 64 + fr, seg = u.pn >> 3, col0 = u.pn * BM + wc * 32 + 8 * fq;
        if (seg == 5) {
            float lb[2][8];
#pragma unroll
            for (int bj = 0; bj < 2; ++bj) { const float* l0 = lbl + (col0 - 5 * 2048) + bj * HALF; const float* l1 = l0 + 2048;
                const f32x4 a0 = *(const f32x4*)l0, a1 = *(const f32x4*)(l0 + 4), b0 = *(const f32x4*)l1, b1 = *(const f32x4*)(l1 + 4);
#pragma unroll
                for (int j = 0; j < 4; ++j) { lb[bj][j] = 1.0f / (1.0f + __expf(b0[j] - a0[j])); lb[bj][4 + j] = 1.0f / (1.0f + __expf(b1[j] - a1[j])); } }
#pragma unroll
            for (int ai = 0; ai < 2; ++ai)
#pragma unroll
                for (int m = 0; m < 4; ++m) { const size_t row = (size_t)(row0 + ai * HALF + m * 16);
#pragma unroll
                    for (int bj = 0; bj < 2; ++bj) { const f32x4 v0 = acc[ai][bj][m][0], v1 = acc[ai][bj][m][1];
                        float g[8];
#pragma unroll
                        for (int j = 0; j < 4; ++j) { g[j] = lb[bj][j] + (1.0f - lb[bj][j]) * sigm(v0[j]); g[4 + j] = lb[bj][4 + j] + (1.0f - lb[bj][4 + j]) * sigm(v1[j]); }
                        u32x4 wg; wg.x = pack_h2(g[0], g[1]); wg.y = pack_h2(g[2], g[3]); wg.z = pack_h2(g[4], g[5]); wg.w = pack_h2(g[6], g[7]);
                        *(u32x4*)(O + row * NPROJ + col0 + bj * HALF) = wg; } }
        } else {
            const bool act = (seg == 3) | (seg == 4) | (seg == 7); const float sc = seg == 4 ? QSCALE : 1.0f;
#pragma unroll
            for (int ai = 0; ai < 2; ++ai)
#pragma unroll
                for (int m = 0; m < 4; ++m) { bf16_t* rowp = O + (size_t)(row0 + ai * HALF + m * 16) * NPROJ + col0;
#pragma unroll
                    for (int bj = 0; bj < 2; ++bj) { f32x4 v0 = acc[ai][bj][m][0], v1 = acc[ai][bj][m][1];
                        if (act) {
#pragma unroll
                            for (int j = 0; j < 4; ++j) { v0[j] = silu(v0[j]) * sc; v1[j] = silu(v1[j]) * sc; } }
                        u32x4 w; w.x = pkbf(v0[0], v0[1]); w.y = pkbf(v0[2], v0[3]); w.z = pkbf(v1[0], v1[1]); w.w = pkbf(v1[2], v1[3]);
                        *(u32x4*)(rowp + bj * HALF) = w; } }
        }
    }
};

__device__ __forceinline__ void p0_tile_info(const Params& p, int tile, const float*& src, int& ld, bf16_t*& dst, int& ldd) {
    if (tile < 2048) { const int kt = tile >> 6, nt = tile & 63; src = p.w_in + (size_t)(kt * 64) * NPROJ + nt * 256; ld = NPROJ;
        dst = (bf16_t*)(p.ws + WS_BT1) + (size_t)(nt * 256) * DM + kt * 64; ldd = DM; }
    else { const int t2 = tile - 2048, kt = t2 >> 3, nt = t2 & 7; src = p.w_out + (size_t)(kt * 64) * DM + nt * 256; ld = DM;
        dst = (bf16_t*)(p.ws + WS_BT2) + (size_t)(nt * 256) * DMIX + kt * 64; ldd = DMIX; }
}
__device__ void phase0(const Params& p, unsigned char* lds) {
    float* T = (float*)lds;
    const int tid = threadIdx.x;
    if (blockIdx.x == 0 && tid == 0) *(unsigned*)(p.ws + WS_CTR) = 0u;
    constexpr int NT = 2048 + 512;
    pg8::f32x4 r[8];
    int tile = blockIdx.x;
    const float* src = nullptr; int ld = 0; bf16_t* dst = nullptr; int ldd = 0;
    p0_tile_info(p, tile < NT ? tile : NT - 1, src, ld, dst, ldd);
#pragma unroll
    for (int i = 0; i < 8; ++i) r[i] = __builtin_nontemporal_load((const pg8::f32x4*)(src + (size_t)(i * 8 + (tid >> 6)) * ld + (tid & 63) * 4));
    while (tile < NT) {
#pragma unroll
        for (int i = 0; i < 8; ++i) { const int k = i * 8 + (tid >> 6), n = (tid & 63) * 4; *(pg8::f32x4*)&T[k * 256 + (n ^ (i << 3))] = r[i]; }
        bf16_t* cdst = dst; const int cldd = ldd;
        const int nxt = tile + gridDim.x;
        p0_tile_info(p, nxt < NT ? nxt : NT - 1, src, ld, dst, ldd);
#pragma unroll
        for (int i = 0; i < 8; ++i) r[i] = __builtin_nontemporal_load((const pg8::f32x4*)(src + (size_t)(i * 8 + (tid >> 6)) * ld + (tid & 63) * 4));
        lds_barrier();
#pragma unroll
        for (int c = 0; c < 4; ++c) { const int q = tid + 512 * c, n = q >> 3, k8 = q & 7; float v[8];
#pragma unroll
            for (int j = 0; j < 8; ++j) v[j] = T[(k8 * 8 + j) * 256 + (n ^ (k8 << 3))];
            *(uint4*)(cdst + (size_t)n * cldd + k8 * 8) = pack8(v); }
        lds_barrier();
        tile = nxt;
    }
    bf16_t* A1 = (bf16_t*)(p.ws + WS_A1);
    constexpr size_t total8 = (size_t)MROWS * DM / 8, pe = (size_t)PROWS * DM;
    const size_t stride = (size_t)gridDim.x * 512;
    for (size_t i = (size_t)blockIdx.x * 512 + tid; i < total8; i += 3 * stride) {
        const size_t i0 = i, i1 = i + stride, i2 = i + 2 * stride;
        const size_t j1 = i1 < total8 ? i1 : i0, j2 = i2 < total8 ? i2 : i0;
        const size_t e0 = i0 * 8, e1 = j1 * 8, e2 = j2 * 8;
        const float* s0 = e0 < pe ? p.x_prompt + e0 : p.x_sample + (e0 - pe);
        const float* s1 = e1 < pe ? p.x_prompt + e1 : p.x_sample + (e1 - pe);
        const float* s2 = e2 < pe ? p.x_prompt + e2 : p.x_sample + (e2 - pe);
        const pg8::f32x4 a0 = __builtin_nontemporal_load((const pg8::f32x4*)s0), b0 = __builtin_nontemporal_load((const pg8::f32x4*)(s0 + 4)), a1 = __builtin_nontemporal_load((const pg8::f32x4*)s1), b1 = __builtin_nontemporal_load((const pg8::f32x4*)(s1 + 4)), a2 = __builtin_nontemporal_load((const pg8::f32x4*)s2), b2 = __builtin_nontemporal_load((const pg8::f32x4*)(s2 + 4));
        { const float v[8] = {a0.x, a0.y, a0.z, a0.w, b0.x, b0.y, b0.z, b0.w}; *(uint4*)(A1 + e0) = pack8(v); }
        if (i1 < total8) { const float v[8] = {a1.x, a1.y, a1.z, a1.w, b1.x, b1.y, b1.z, b1.w}; *(uint4*)(A1 + e1) = pack8(v); }
        if (i2 < total8) { const float v[8] = {a2.x, a2.y, a2.z, a2.w, b2.x, b2.y, b2.z, b2.w}; *(uint4*)(A1 + e2) = pack8(v); }
    }
}

__device__ __forceinline__ pg8::bf16x8 ldfrag(const unsigned char* p) { const uint4 r = *(const uint4*)p; return __builtin_bit_cast(pg8::bf16x8, r); }
__device__ void hgrn_prompt_item(const Params& p, unsigned char* lds, int it) {
    using pg8::bf16x8; using pg8::f32x4;
    const int h = it & 15, b = it >> 4;
    unsigned char* QE = lds; unsigned char* KE = lds + 18432; unsigned char* KTT = lds + 36864; unsigned char* VT = lds + 57344;
    float* TOT = (float*)(lds + 77824); float* DL = (float*)(lds + 81920); float* OB = (float*)(lds + 82432);
    int tid = threadIdx.x; asm volatile("" : "+v"(tid));
    const int lane = tid & 63, w = tid >> 6, fr = lane & 15, kq = lane >> 4;
    const size_t row0 = (size_t)b * 2048;
    bf16_t* mix = (bf16_t*)(p.ws + WS_MIX);
    const char* pbase = (const char*)(p.ws + WS_PROJ) + (row0 * NPROJ + 4 * 2048 + h * 128) * 2;
    const int m16 = lane & 15;
    const int qoff = (32 * (lane >> 4) + 8 * ((m16 & 7) >> 1) + 4 * (m16 >> 3) + 2 * (m16 & 1)) * 2;
    const int sc0 = ((4 * (w >> 2) + 2 * (w & 1)) ^ (lane & 7)) * 16 + 8 * ((w >> 1) & 1), sc1 = ((4 * (w >> 2) + 2 * (w & 1) + 1) ^ (lane & 7)) * 16 + 8 * ((w >> 1) & 1);
    const unsigned voff = (unsigned)((8 * w * NPROJ + 2 * lane) * 2);
    unsigned rq[8], rf[8], rv[8];
#define HG_PF(c) do { const char* cb = pbase + (size_t)(c) * 64 * NPROJ * 2; _Pragma("unroll") for (int i = 0; i < 8; ++i) { const char* ri = cb + (size_t)i * NPROJ * 2; \
        rq[i] = *(const unsigned*)(ri + voff); rf[i] = *(const unsigned*)(ri + 4096 + voff); rv[i] = *(const unsigned*)(ri + 8192 + voff); } } while (0)
    HG_PF(0);
    f32x4 S[8];
#pragma unroll
    for (int i = 0; i < 8; ++i) S[i] = (f32x4){0.f, 0.f, 0.f, 0.f};
    for (int c = 0; c < 32; ++c) {
        float e0[8], e1[8]; float a0 = 1.f, a1 = 1.f;
#pragma unroll
        for (int i = 0; i < 8; ++i) { a0 *= h2lo(rf[i]); a1 *= h2hi(rf[i]); e0[i] = a0; e1[i] = a1; }
        *(float2*)&TOT[w * 128 + 2 * lane] = make_float2(a0, a1);
        lds_barrier();
        float off0 = 1.f, off1 = 1.f, tot0 = 1.f, tot1 = 1.f;
#pragma unroll
        for (int ww = 0; ww < 8; ++ww) { const float2 t = *(const float2*)&TOT[ww * 128 + 2 * lane]; if (ww < w) { off0 *= t.x; off1 *= t.y; } tot0 *= t.x; tot1 *= t.y; }
        if (w == 0) *(float2*)&DL[2 * lane] = make_float2(tot0, tot1);
        float kt0[8], kt1[8];
#pragma unroll
        for (int i = 0; i < 8; ++i) { const float E0 = off0 * e0[i], E1 = off1 * e1[i];
            const float ke0 = (1.0f - h2lo(rf[i])) * __builtin_amdgcn_rcpf(E0), ke1 = (1.0f - h2hi(rf[i])) * __builtin_amdgcn_rcpf(E1);
            kt0[i] = ke0 * tot0; kt1[i] = ke1 * tot1;
            const int t = 8 * w + i;
            *(unsigned*)(QE + t * 288 + qoff) = pkbf(bflo(rq[i]) * E0, bfhi(rq[i]) * E1);
            *(unsigned*)(KE + t * 288 + qoff) = pkbf(ke0, ke1); }
        { unsigned char* r0 = KTT + (2 * lane) * 128; unsigned char* r1 = r0 + 128;
          *(uint2*)(r0 + sc0) = make_uint2(pkbf(kt0[0], kt0[1]), pkbf(kt0[2], kt0[3])); *(uint2*)(r0 + sc1) = make_uint2(pkbf(kt0[4], kt0[5]), pkbf(kt0[6], kt0[7]));
          *(uint2*)(r1 + sc0) = make_uint2(pkbf(kt1[0], kt1[1]), pkbf(kt1[2], kt1[3])); *(uint2*)(r1 + sc1) = make_uint2(pkbf(kt1[4], kt1[5]), pkbf(kt1[6], kt1[7])); }
        { unsigned char* r0 = VT + (2 * lane) * 128; unsigned char* r1 = r0 + 128;
          *(uint2*)(r0 + sc0) = make_uint2((rv[0] & 0xffffu) | (rv[1] << 16), (rv[2] & 0xffffu) | (rv[3] << 16)); *(uint2*)(r0 + sc1) = make_uint2((rv[4] & 0xffffu) | (rv[5] << 16), (rv[6] & 0xffffu) | (rv[7] << 16));
          *(uint2*)(r1 + sc0) = make_uint2((rv[0] >> 16) | (rv[1] & 0xffff0000u), (rv[2] >> 16) | (rv[3] & 0xffff0000u)); *(uint2*)(r1 + sc1) = make_uint2((rv[4] >> 16) | (rv[5] & 0xffff0000u), (rv[6] >> 16) | (rv[7] & 0xffff0000u)); }
        if (c + 1 < 32) HG_PF(c + 1);
        lds_barrier();
        uint4 rz[2]; float4 nba, nbb;
        { const int v8 = (tid & 15) * 8; const bf16_t* zp = (const bf16_t*)(pbase + (size_t)c * 64 * NPROJ * 2) + 3 * 2048 + v8;
          rz[0] = *(const uint4*)(zp + (size_t)(tid >> 4) * NPROJ); rz[1] = *(const uint4*)(zp + (size_t)(32 + (tid >> 4)) * NPROJ);
          nba = *(const float4*)(p.norm_b + h * 128 + v8); nbb = *(const float4*)(p.norm_b + h * 128 + v8 + 4); }
        bf16x8 qf[4][4], kf[2][4];
#pragma unroll
        for (int ti = 0; ti < 4; ++ti)
#pragma unroll
            for (int ks = 0; ks < 4; ++ks) qf[ti][ks] = ldfrag(QE + (16 * ti + fr) * 288 + ks * 64 + kq * 16);
#pragma unroll
        for (int ks = 0; ks < 4; ++ks) kf[0][ks] = ldfrag(KE + fr * 288 + ks * 64 + kq * 16);
        bf16x8 Sb[4];
#pragma unroll
        for (int ks = 0; ks < 4; ++ks) { const f32x4 x = S[2 * ks], y = S[2 * ks + 1];
            const uint4 r = make_uint4(pkbf(x[0], x[1]), pkbf(x[2], x[3]), pkbf(y[0], y[1]), pkbf(y[2], y[3])); Sb[ks] = __builtin_bit_cast(bf16x8, r); }
        f32x4 oacc[4];
#pragma unroll
        for (int ti = 0; ti < 4; ++ti) oacc[ti] = (f32x4){0.f, 0.f, 0.f, 0.f};
#pragma unroll
        for (int ks = 0; ks < 4; ++ks)
#pragma unroll
            for (int ti = 0; ti < 4; ++ti) oacc[ti] = __builtin_amdgcn_mfma_f32_16x16x32_bf16(qf[ti][ks], Sb[ks], oacc[ti], 0, 0, 0);
        uint2 ap[4][4];
#pragma unroll
        for (int ti = 0; ti < 4; ++ti)
#pragma unroll
            for (int si = 0; si < 4; ++si) ap[ti][si] = make_uint2(0u, 0u);
        bf16x8 vf[2], ktf[8][2]; float4 dlv[8];
#pragma unroll
        for (int si = 0; si < 4; ++si) {
            if (si < 3) {
#pragma unroll
                for (int ks = 0; ks < 4; ++ks) kf[(si + 1) & 1][ks] = ldfrag(KE + (16 * (si + 1) + fr) * 288 + ks * 64 + kq * 16); }
            else {
#pragma unroll
                for (int ss = 0; ss < 2; ++ss) vf[ss] = ldfrag(VT + (16 * w + fr) * 128 + (((4 * ss + kq) * 16) ^ (((fr >> 1) & 7) * 16)));
#pragma unroll
                for (int kt = 0; kt < 8; ++kt) dlv[kt] = *(const float4*)&DL[16 * kt + 4 * kq]; }
            f32x4 d[4];
#pragma unroll
            for (int ti = si; ti < 4; ++ti) d[ti] = (f32x4){0.f, 0.f, 0.f, 0.f};
#pragma unroll
            for (int ks = 0; ks < 4; ++ks)
#pragma unroll
                for (int ti = si; ti < 4; ++ti) d[ti] = __builtin_amdgcn_mfma_f32_16x16x32_bf16(kf[si & 1][ks], qf[ti][ks], d[ti], 0, 0, 0);
#pragma unroll
            for (int j = 0; j < 4; ++j) d[si][j] = (4 * kq + j <= fr) ? d[si][j] : 0.f;
#pragma unroll
            for (int ti = si; ti < 4; ++ti) ap[ti][si] = make_uint2(pkbf(d[ti][0], d[ti][1]), pkbf(d[ti][2], d[ti][3])); }
#pragma unroll
        for (int kt = 0; kt < 8; ++kt)
#pragma unroll
            for (int ss = 0; ss < 2; ++ss) ktf[kt][ss] = ldfrag(KTT + (16 * kt + fr) * 128 + (((4 * ss + kq) * 16) ^ (((fr >> 1) & 7) * 16)));
#pragma unroll
        for (int ti = 0; ti < 4; ++ti)
#pragma unroll
            for (int ss = 0; ss < 2; ++ss) if (2 * ss <= ti) { const uint4 r = make_uint4(ap[ti][2 * ss].x, ap[ti][2 * ss].y, ap[ti][2 * ss + 1].x, ap[ti][2 * ss + 1].y);
                oacc[ti] = __builtin_amdgcn_mfma_f32_16x16x32_bf16(__builtin_bit_cast(bf16x8, r), vf[ss], oacc[ti], 0, 0, 0); }
#pragma unroll
        for (int kt = 0; kt < 8; ++kt) { S[kt][0] *= dlv[kt].x; S[kt][1] *= dlv[kt].y; S[kt][2] *= dlv[kt].z; S[kt][3] *= dlv[kt].w; }
#pragma unroll
        for (int ss = 0; ss < 2; ++ss)
#pragma unroll
            for (int kt = 0; kt < 8; ++kt) S[kt] = __builtin_amdgcn_mfma_f32_16x16x32_bf16(ktf[kt][ss], vf[ss], S[kt], 0, 0, 0);
#pragma unroll
        for (int ti = 0; ti < 4; ++ti)
#pragma unroll
            for (int j = 0; j < 4; ++j) OB[(16 * ti + 4 * kq + j) * 128 + 16 * w + fr] = oacc[ti][j];
        lds_barrier();
#pragma unroll
        for (int ps = 0; ps < 2; ++ps) { const int t = ps * 32 + (tid >> 4), v8 = (tid & 15) * 8;
            const float4 oa = *(const float4*)&OB[t * 128 + v8], ob = *(const float4*)&OB[t * 128 + v8 + 4];
            const float o[8] = {oa.x, oa.y, oa.z, oa.w, ob.x, ob.y, ob.z, ob.w}; const float nb[8] = {nba.x, nba.y, nba.z, nba.w, nbb.x, nbb.y, nbb.z, nbb.w}; float z[8]; unpack8(rz[ps], z);
            float ss = 0.f;
#pragma unroll
            for (int j = 0; j < 8; ++j) ss += o[j] * o[j];
            ss = row16_sum(ss);
            const float sc = rsqrtf(ss * (1.0f / 128.0f) + EPSV);
            float y[8];
#pragma unroll
            for (int j = 0; j < 8; ++j) y[j] = o[j] * sc * nb[j] * z[j];
            *(uint4*)(mix + (row0 + (size_t)c * 64 + t) * DMIX + 2048 + h * 128 + v8) = pack8(y); }
    }
#undef HG_PF
    float* sd = p.out + OFF_NHP + ((size_t)(b * 16 + h) * 128 + 4 * kq) * 128 + 16 * w + fr;
#pragma unroll
    for (int kt = 0; kt < 8; ++kt)
#pragma unroll
        for (int j = 0; j < 4; ++j) sd[(size_t)(16 * kt + j) * 128] = S[kt][j];
    lds_barrier();
}

__device__ void hgrn_sample_item(const Params& p, unsigned char* lds, int it) {
    const int h = it & 15, b = it >> 4;
    float* Q = (float*)lds; float* F = Q + 1024; float* Op = F + 1024;
    int tid = threadIdx.x; asm volatile("" : "+v"(tid));
    const int lane = tid & 63, w = tid >> 6;
    const bf16_t* proj = (const bf16_t*)(p.ws + WS_PROJ);
    const size_t soff = (size_t)it * 16384 + (size_t)(16 * w) * 128 + 2 * lane;
    const float* s0 = p.state_hgrn + soff;
    float2 S[16];
#pragma unroll
    for (int j = 0; j < 16; ++j) { const f32x2_t t = __builtin_nontemporal_load((const f32x2_t*)(s0 + j * 128)); S[j] = make_float2(t.x, t.y); }
    const size_t row0 = (size_t)PROWS + (size_t)b * 8;
    float2 vv[8];
#pragma unroll
    for (int t = 0; t < 8; ++t) { const unsigned u = *(const unsigned*)(proj + (row0 + t) * NPROJ + 6 * 2048 + h * 128 + 2 * lane); vv[t] = make_float2(bflo(u), bfhi(u)); }
    if (tid < 128) { const int t = tid >> 4, pk = (tid & 15) * 8;
        const bf16_t* qp = proj + (row0 + t) * NPROJ + 4 * 2048 + h * 128 + pk;
        const uint4 rq = *(const uint4*)qp, rf = *(const uint4*)(qp + 2048);
        float q[8], f[8]; unpack8(rq, q);
        f[0] = h2lo(rf.x); f[1] = h2hi(rf.x); f[2] = h2lo(rf.y); f[3] = h2hi(rf.y); f[4] = h2lo(rf.z); f[5] = h2hi(rf.z); f[6] = h2lo(rf.w); f[7] = h2hi(rf.w);
        *(float4*)&Q[t * 128 + pk] = make_float4(q[0], q[1], q[2], q[3]); *(float4*)&Q[t * 128 + pk + 4] = make_float4(q[4], q[5], q[6], q[7]);
        *(float4*)&F[t * 128 + pk] = make_float4(f[0], f[1], f[2], f[3]); *(float4*)&F[t * 128 + pk + 4] = make_float4(f[4], f[5], f[6], f[7]); }
    lds_barrier();
#pragma unroll
    for (int t = 0; t < 8; ++t) { float2 op = make_float2(0.f, 0.f);
#pragma unroll
        for (int j4 = 0; j4 < 4; ++j4) { const float4 f4 = *(const float4*)&F[t * 128 + 16 * w + j4 * 4], q4 = *(const float4*)&Q[t * 128 + 16 * w + j4 * 4];
            const float ff[4] = {f4.x, f4.y, f4.z, f4.w}, qq[4] = {q4.x, q4.y, q4.z, q4.w};
#pragma unroll
            for (int j = 0; j < 4; ++j) { float2& s = S[j4 * 4 + j]; s.x = ff[j] * (s.x - vv[t].x) + vv[t].x; s.y = ff[j] * (s.y - vv[t].y) + vv[t].y; op.x += s.x * qq[j]; op.y += s.y * qq[j]; } }
        *(float2*)&Op[(w * 8 + t) * 128 + 2 * lane] = op; }
    float* d = p.out + OFF_NHS + soff;
#pragma unroll
    for (int j = 0; j < 16; ++j) { const f32x2_t t = {S[j].x, S[j].y}; __builtin_nontemporal_store(t, (f32x2_t*)(d + j * 128)); }
    lds_barrier();
    { const int idx = tid * 2, t = idx >> 7, v = idx & 127; float2 s = make_float2(0.f, 0.f);
#pragma unroll
      for (int ww = 0; ww < 8; ++ww) { const float2 o = *(const float2*)&Op[(ww * 8 + t) * 128 + v]; s.x += o.x; s.y += o.y; }
      float ss = row16_sum(s.x * s.x + s.y * s.y); ss += __shfl_xor(ss, 16); ss += __shfl_xor(ss, 32);
      const float sc = rsqrtf(ss * (1.0f / 128.0f) + EPSV);
      const float2 nb = *(const float2*)(p.norm_b + h * 128 + v);
      const unsigned zz = *(const unsigned*)(proj + (row0 + t) * NPROJ + 7 * 2048 + h * 128 + v);
      *(unsigned*)((bf16_t*)(p.ws + WS_MIX) + (row0 + t) * DMIX + 2048 + h * 128 + v) = pkbf(s.x * sc * nb.x * bflo(zz), s.y * sc * nb.y * bfhi(zz)); }
    lds_barrier();
}

__device__ void conv_item(const Params& p, int item) {
    int tid = threadIdx.x; asm volatile("" : "+v"(tid));
    const int half = tid >> 8, c0 = (tid & 255) * 8;
    const bf16_t* proj = (const bf16_t*)(p.ws + WS_PROJ);
    bf16_t* mix = (bf16_t*)(p.ws + WS_MIX);
    size_t row0; int t0, L, T; float* ncout; bool sample;
    if (item < 256) { const int g = item * 2 + half; row0 = (size_t)g * 16; const int b = g >> 7; t0 = (g & 127) * 16; L = 16; T = 2048; ncout = p.out + OFF_NCP + (size_t)b * 2 * 2048; sample = false; }
    else { const int s = (item - 256) * 2 + half; row0 = (size_t)PROWS + (size_t)s * 8; t0 = 0; L = 8; T = 8; ncout = p.out + OFF_NCS + (size_t)s * 2 * 2048; sample = true; }
    float w0[8], w1[8], w2[8], na[8], u1[8], u2[8];
    { const float4 a = *(const float4*)(p.conv_w + c0), b = *(const float4*)(p.conv_w + c0 + 4); w0[0] = a.x; w0[1] = a.y; w0[2] = a.z; w0[3] = a.w; w0[4] = b.x; w0[5] = b.y; w0[6] = b.z; w0[7] = b.w; }
    { const float4 a = *(const float4*)(p.conv_w + 2048 + c0), b = *(const float4*)(p.conv_w + 2048 + c0 + 4); w1[0] = a.x; w1[1] = a.y; w1[2] = a.z; w1[3] = a.w; w1[4] = b.x; w1[5] = b.y; w1[6] = b.z; w1[7] = b.w; }
    { const float4 a = *(const float4*)(p.conv_w + 4096 + c0), b = *(const float4*)(p.conv_w + 4096 + c0 + 4); w2[0] = a.x; w2[1] = a.y; w2[2] = a.z; w2[3] = a.w; w2[4] = b.x; w2[5] = b.y; w2[6] = b.z; w2[7] = b.w; }
    { const float4 a = *(const float4*)(p.norm_a + c0), b = *(const float4*)(p.norm_a + c0 + 4); na[0] = a.x; na[1] = a.y; na[2] = a.z; na[3] = a.w; na[4] = b.x; na[5] = b.y; na[6] = b.z; na[7] = b.w; }
    if (sample) { const float* sc = p.state_conv + (size_t)((item - 256) * 2 + half) * 2 * 2048 + c0;
        const float4 a = *(const float4*)sc, b = *(const float4*)(sc + 4), c = *(const float4*)(sc + 2048), d = *(const float4*)(sc + 2048 + 4);
        u2[0] = a.x; u2[1] = a.y; u2[2] = a.z; u2[3] = a.w; u2[4] = b.x; u2[5] = b.y; u2[6] = b.z; u2[7] = b.w;
        u1[0] = c.x; u1[1] = c.y; u1[2] = c.z; u1[3] = c.w; u1[4] = d.x; u1[5] = d.y; u1[6] = d.z; u1[7] = d.w; }
    else if (t0 == 0) {
#pragma unroll
        for (int j = 0; j < 8; ++j) { u1[j] = 0.f; u2[j] = 0.f; } }
    else { const bf16_t* r2 = proj + (row0 - 2) * NPROJ + c0; const bf16_t* r1 = r2 + NPROJ;
        const uint4 v2 = *(const uint4*)r2, cc2 = *(const uint4*)(r2 + 2 * 2048), v1 = *(const uint4*)r1, cc1 = *(const uint4*)(r1 + 2 * 2048);
        float a[8], b[8]; unpack8(v2, a); unpack8(cc2, b);
#pragma unroll
        for (int j = 0; j < 8; ++j) u2[j] = a[j] * b[j];
        unpack8(v1, a); unpack8(cc1, b);
#pragma unroll
        for (int j = 0; j < 8; ++j) u1[j] = a[j] * b[j]; }
    for (int tb = 0; tb < L; tb += 4) {
        uint4 rv[4], rb[4], rc[4], rz[4];
#pragma unroll
        for (int i = 0; i < 4; ++i) { const bf16_t* r = proj + (row0 + tb + i) * NPROJ + c0; rv[i] = ntl16(r); rb[i] = ntl16(r + 2048); rc[i] = ntl16(r + 4096); rz[i] = ntl16(r + 6144); }
#pragma unroll
        for (int i = 0; i < 4; ++i) {
            float v[8], bb[8], cc[8], z[8], u[8], pre[8]; unpack8(rv[i], v); unpack8(rb[i], bb); unpack8(rc[i], cc); unpack8(rz[i], z);
            float ss = 0.f;
#pragma unroll
            for (int j = 0; j < 8; ++j) { u[j] = cc[j] * v[j]; const float cv = w0[j] * u2[j] + w1[j] * u1[j] + w2[j] * u[j]; pre[j] = bb[j] * cv; ss += pre[j] * pre[j]; }
            ss = row16_sum(ss);
            const float sc = rsqrtf(ss * (1.0f / 128.0f) + EPSV);
            float y[8];
#pragma unroll
            for (int j = 0; j < 8; ++j) { y[j] = pre[j] * sc * na[j] * z[j]; u2[j] = u1[j]; u1[j] = u[j]; }
            *(uint4*)(mix + (row0 + tb + i) * DMIX + c0) = pack8(y);
            const int t = t0 + tb + i;
            if (t >= T - 2) { float* d = ncout + (size_t)(t - (T - 2)) * 2048 + c0; *(float4*)d = make_float4(u[0], u[1], u[2], u[3]); *(float4*)(d + 4) = make_float4(u[4], u[5], u[6], u[7]); }
        }
    }
}

__device__ void phase2(const Params& p, unsigned char* lds) {
    unsigned* ctr = (unsigned*)(p.ws + WS_CTR);
    volatile int* slot = (volatile int*)(lds + LDS_STAGE + 16);
    constexpr int N_ITEMS = 64 + 2048 + 320;
    const int tid = threadIdx.x;
#ifdef STATIC_QUEUE
    for (int item = blockIdx.x; item < N_ITEMS; item += gridDim.x) {
        if (item < 64) hgrn_prompt_item(p, lds, item);
        else if (item < 64 + 2048) hgrn_sample_item(p, lds, item - 64);
        else conv_item(p, item - (64 + 2048));
        lds_barrier();
    }
    return;
#endif
    const bool pin = gridDim.x >= 256;
    if (tid == 0) *slot = pin ? ((blockIdx.x < 64) ? (int)blockIdx.x : 64 + (int)atomicAdd(ctr, 1u)) : (int)atomicAdd(ctr, 1u);
    lds_barrier();
    int item = *slot;
    lds_barrier();
    while (item < N_ITEMS) {
        unsigned nxt = 0;
        if (tid == 0) nxt = (pin ? 64u : 0u) + atomicAdd(ctr, 1u);
#ifndef PROBE_ITEM
#define PROBE_ITEM 0
#endif
        const int reps_a = (PROBE_ITEM == 1 && p.ph_hi == 6) ? 2 : 1, reps_b = (PROBE_ITEM == 2 && p.ph_hi == 6) ? 2 : 1, reps_c = (PROBE_ITEM == 3 && p.ph_hi == 6) ? 2 : 1;
        if (item < 64) { for (int r = 0; r < reps_a; ++r) hgrn_prompt_item(p, lds, item); }
        else if (item < 64 + 2048) { for (int r = 0; r < reps_b; ++r) hgrn_sample_item(p, lds, item - 64); }
        else { for (int r = 0; r < reps_c; ++r) conv_item(p, item - (64 + 2048)); }
        if (tid == 0) *slot = (int)nxt;
        lds_barrier();
        item = *slot;
        lds_barrier();
    }
}

__device__ void phase3(const Params& p) {
    const int tid = threadIdx.x, half = tid >> 8, c0 = (tid & 255) * 8;
    const bf16_t* proj = (const bf16_t*)(p.ws + WS_PROJ);
    const float* ows = (const float*)(p.ws + WS_O);
    bf16_t* mix = (bf16_t*)(p.ws + WS_MIX);
    float nb[8];
    { const float4 a = *(const float4*)(p.norm_b + c0), b = *(const float4*)(p.norm_b + c0 + 4); nb[0] = a.x; nb[1] = a.y; nb[2] = a.z; nb[3] = a.w; nb[4] = b.x; nb[5] = b.y; nb[6] = b.z; nb[7] = b.w; }
    for (int base = blockIdx.x * 8; base < MROWS; base += gridDim.x * 8) {
        float4 oa[4], ob[4]; uint4 rz[4];
#pragma unroll
        for (int i = 0; i < 4; ++i) { const size_t r = (size_t)base + half * 4 + i; oa[i] = *(const float4*)(ows + r * DM + c0); ob[i] = *(const float4*)(ows + r * DM + c0 + 4); rz[i] = *(const uint4*)(proj + r * NPROJ + 7 * 2048 + c0); }
#pragma unroll
        for (int i = 0; i < 4; ++i) { const size_t r = (size_t)base + half * 4 + i;
            const float o[8] = {oa[i].x, oa[i].y, oa[i].z, oa[i].w, ob[i].x, ob[i].y, ob[i].z, ob[i].w}; float z[8]; unpack8(rz[i], z);
            float ss = 0.f;
#pragma unroll
            for (int j = 0; j < 8; ++j) ss += o[j] * o[j];
            ss = row16_sum(ss);
            const float sc = rsqrtf(ss * (1.0f / 128.0f) + EPSV);
            float y[8];
#pragma unroll
            for (int j = 0; j < 8; ++j) y[j] = o[j] * sc * nb[j] * z[j];
            *(uint4*)(mix + r * DMIX + 2048 + c0) = pack8(y); }
    }
}

__device__ void phase5(const Params& p, unsigned char* lds) {
    const int tid = threadIdx.x, lane = tid & 63, w = __builtin_amdgcn_readfirstlane(tid >> 6);
    const float* hws = (const float*)(p.ws + WS_H);
    float* LG = (float*)lds; float* LB = LG + 2048;
    *(float4*)&LG[tid * 4] = *(const float4*)(p.ln_gain + tid * 4); *(float4*)&LB[tid * 4] = *(const float4*)(p.ln_bias + tid * 4);
    lds_barrier();
    auto fin = [&](float4 (&r)[8], const int row) __attribute__((always_inline)) {
        float s = 0.f;
#pragma unroll
        for (int i = 0; i < 8; ++i) s += (r[i].x + r[i].y) + (r[i].z + r[i].w);
#pragma unroll
        for (int o = 32; o > 0; o >>= 1) s += __shfl_xor(s, o);
        const float mu = s * (1.0f / 2048.0f); float q = 0.f;
#pragma unroll
        for (int i = 0; i < 8; ++i) { r[i].x -= mu; r[i].y -= mu; r[i].z -= mu; r[i].w -= mu; q += (r[i].x * r[i].x + r[i].y * r[i].y) + (r[i].z * r[i].z + r[i].w * r[i].w); }
#pragma unroll
        for (int o = 32; o > 0; o >>= 1) q += __shfl_xor(q, o);
        const float rs = rsqrtf(q * (1.0f / 2048.0f) + EPSV);
        float* yr = p.out + OFF_Y + (size_t)row * DM;
#pragma unroll
        for (int i = 0; i < 8; ++i) { const int col = i * 256 + lane * 4; const float4 g = *(const float4*)&LG[col], bb = *(const float4*)&LB[col];
            const pg8::f32x4 yv = {r[i].x * rs * g.x + bb.x, r[i].y * rs * g.y + bb.y, r[i].z * rs * g.z + bb.z, r[i].w * rs * g.w + bb.w}; __builtin_nontemporal_store(yv, (pg8::f32x4*)(yr + col)); }
    };
    if (w < 4) {
        for (int sr = blockIdx.x * 4 + w; sr < SROWS; sr += gridDim.x * 4) {
            const float* xr = p.x_sample + (size_t)sr * DM;
            const float* hp = (const float*)(p.ws + WS_HPART) + (size_t)sr * DM;
            float4 r[8];
#pragma unroll
            for (int i = 0; i < 8; ++i) { const pg8::f32x4 x4 = __builtin_nontemporal_load((const pg8::f32x4*)(xr + i * 256 + lane * 4)); r[i] = make_float4(ALPHA * x4.x, ALPHA * x4.y, ALPHA * x4.z, ALPHA * x4.w); }
#pragma unroll 2
            for (int kp = 0; kp < 8; ++kp) {
#pragma unroll
                for (int i = 0; i < 8; ++i) { const pg8::f32x4 t = __builtin_nontemporal_load((const pg8::f32x4*)(hp + (size_t)kp * SROWS * DM + i * 256 + lane * 4)); r[i].x += t.x; r[i].y += t.y; r[i].z += t.z; r[i].w += t.w; } }
            fin(r, PROWS + sr);
        }
    }
    const int stride = gridDim.x * 8;
    int row = blockIdx.x * 8 + w;
    while (row < PROWS) {
        int nv = 1;
#pragma unroll
        for (int k = 1; k < 4; ++k) nv += (row + k * stride < PROWS) ? 1 : 0;
        float4 rr[4][8];
#pragma unroll
        for (int k = 0; k < 4; ++k) { const float* hk = hws + (size_t)(k < nv ? row + k * stride : row) * DM;
#pragma unroll
            for (int i = 0; i < 8; ++i) { const pg8::f32x4 t = __builtin_nontemporal_load((const pg8::f32x4*)(hk + i * 256 + lane * 4)); rr[k][i] = make_float4(t.x, t.y, t.z, t.w); } }
#pragma unroll
        for (int k = 0; k < 4; ++k) if (k < nv) fin(rr[k], row + k * stride);
        row += nv * stride;
    }
}


#define XB_TMO      128
#define XB_XCNT(j)  (256  + 64 * (j))
#define XB_XSUB(j)  (1280 + 64 * (j))
#define XB_XGEN(j)  (2304 + 64 * (j))
#define XB_TOP      3328
#define XB_TOPGEN   3392
#define XCD_BAR_WORDS 3456
#define XB_SPIN_CAP (1u << 18)
__device__ __forceinline__ unsigned xb_ld(unsigned* p)              { return __hip_atomic_load(p, __ATOMIC_RELAXED, __HIP_MEMORY_SCOPE_AGENT); }
__device__ __forceinline__ unsigned xb_add(unsigned* p, unsigned v) { return __hip_atomic_fetch_add(p, v, __ATOMIC_RELAXED, __HIP_MEMORY_SCOPE_AGENT); }
__device__ __forceinline__ unsigned xb_xcc_id() { return (unsigned)__builtin_amdgcn_s_getreg((3 << 11) | 20) & 0xFu; }
#define XB_SPIN(cond, bar) do { unsigned _sp = 0; while (cond) { __builtin_amdgcn_s_sleep(1); \
    if ((++_sp & 255u) == 0u) { if (xb_ld(&(bar)[XB_TMO])) break; if (_sp > XB_SPIN_CAP) { atomicAdd(&(bar)[XB_TMO], 1u); break; } } } } while (0)
struct XcdBarrier { unsigned* bar; unsigned x; volatile PG8_LAS unsigned* st; };
__device__ __forceinline__ XcdBarrier xcd_barrier_post(unsigned* bar, volatile PG8_LAS unsigned* st) {
    XcdBarrier b; b.bar = bar; b.x = xb_xcc_id(); b.st = st;
    if (threadIdx.x == 0) (void)xb_add(&bar[XB_XCNT(b.x)], 1u);
    return b;
}
__device__ __forceinline__ void xcd_barrier_complete(unsigned* bar, unsigned x, unsigned& nloc, unsigned& nx) {
    const unsigned G = gridDim.x * gridDim.y * gridDim.z;
    unsigned sum, cnt, mine, sp = 0u;
    for (;;) {
        sum = 0u; cnt = 0u; mine = 0u;
#pragma unroll
        for (unsigned j = 0; j < 16; ++j) { const unsigned c = xb_ld(&bar[XB_XCNT(j)]); sum += c; cnt += (c > 0u) ? 1u : 0u; mine = (j == x) ? c : mine; }
        if (sum == G) break;
        __builtin_amdgcn_s_sleep(1);
        if ((++sp & 255u) == 0u) { if (xb_ld(&bar[XB_TMO])) break; if (sp > XB_SPIN_CAP) { atomicAdd(&bar[XB_TMO], 1u); break; } }
    }
    nloc = mine > 0u ? mine : 1u; nx = cnt > 0u ? cnt : 1u;
}
__device__ __forceinline__ void xcd_barrier(const XcdBarrier& b) {
    asm volatile("s_waitcnt vmcnt(0)" ::: "memory");
    __syncthreads();
    if (threadIdx.x == 0) {
        unsigned* bar = b.bar;
        __builtin_amdgcn_s_waitcnt(0);
        unsigned nloc = b.st[0], nx = b.st[1];
        if (nloc == 0u) { xcd_barrier_complete(bar, b.x, nloc, nx); b.st[0] = nloc; b.st[1] = nx; }
        const unsigned old = xb_add(&bar[XB_XSUB(b.x)], 1u);
        const unsigned gen = old / nloc;
        if (old + 1u == (gen + 1u) * nloc) {
            __builtin_amdgcn_fence(__ATOMIC_RELEASE, "agent");
            asm volatile("s_waitcnt vmcnt(0)" ::: "memory");
            const unsigned og = xb_add(&bar[XB_TOP], 1u);
            const unsigned tg = og / nx;
            if (og + 1u == (tg + 1u) * nx) xb_add(&bar[XB_TOPGEN], 1u);
            else XB_SPIN(xb_ld(&bar[XB_TOPGEN]) == tg, bar);
            __builtin_amdgcn_fence(__ATOMIC_ACQUIRE, "agent");
            xb_add(&bar[XB_XGEN(b.x)], 1u);
            asm volatile("s_waitcnt vmcnt(0)" ::: "memory");
        } else {
            XB_SPIN(xb_ld(&bar[XB_XGEN(b.x)]) == gen, bar);
            __builtin_amdgcn_fence(__ATOMIC_ACQUIRE, "agent");
            asm volatile("s_waitcnt vmcnt(0)" ::: "memory");
        }
    }
    __syncthreads();
}

struct EpiRes {
    static constexpr bool PERM = false, AFTER_DRAIN = false;
    float* C; int ldc; const float* X;
    __device__ __forceinline__ void operator()(const pg8::f32x4 (&acc)[2][2][4][2], const pg8::Unit& u, int wr, int wc, int fr, int fq) const {
        using namespace pg8;
        const int row0 = u.pm * BM + wr * 64 + fr, col0 = u.pn * BM + wc * 32 + 4 * fq;
#pragma unroll
        for (int ai = 0; ai < 2; ++ai) {
            f32x4 xv[4][2][2];
#pragma unroll
            for (int m = 0; m < 4; ++m) { const float* xp = X + (size_t)(row0 + ai * HALF + m * 16) * ldc + col0;
#pragma unroll
                for (int bj = 0; bj < 2; ++bj)
#pragma unroll
                    for (int n = 0; n < 2; ++n) xv[m][bj][n] = __builtin_nontemporal_load((const f32x4*)(xp + bj * HALF + n * 16)); }
#pragma unroll
            for (int m = 0; m < 4; ++m) { float* rowp = C + (size_t)(row0 + ai * HALF + m * 16) * ldc + col0;
#pragma unroll
                for (int bj = 0; bj < 2; ++bj)
#pragma unroll
                    for (int n = 0; n < 2; ++n) *(f32x4*)(rowp + bj * HALF + n * 16) = acc[ai][bj][m][n] + ALPHA * xv[m][bj][n]; } }
    }
};
struct OneUnit { int pm, pn;
    __device__ bool next(int i, pg8::Unit& u) const { if (i) return false; u.pm = pm; u.pn = pn; return true; }
    __device__ __forceinline__ void a_ready(const pg8::Unit&) const {}
    __device__ __forceinline__ void done(const pg8::Unit&) const {} };
__global__ __launch_bounds__(512, 2) void mega(Params p) {
    extern __shared__ __attribute__((aligned(16))) unsigned char shm[];
    cg::grid_group grid = cg::this_grid();
    if (p.ph_lo < 0) grid.sync();
    const bool fused = p.ph_hi - p.ph_lo > 1;
    volatile PG8_LAS unsigned* st = (volatile PG8_LAS unsigned*)(PG8_LAS unsigned char*)(shm + LDS_STAGE);
    if (threadIdx.x == 0) { st[0] = 0u; st[1] = 0u; }
    __syncthreads();
    XcdBarrier xb; xb.bar = (unsigned*)(p.ws + WS_BAR); xb.x = 0; xb.st = st;
    if (fused) xb = xcd_barrier_post((unsigned*)(p.ws + WS_BAR), st);
#define SEAM() xcd_barrier(xb)
#ifndef PROBE_REP
#define PROBE_REP 0
#endif
#define RUN_PHASE(i, ...) if (p.ph_lo <= (i) && (i) < p.ph_hi) { if ((i) > p.ph_lo) SEAM(); __VA_ARGS__ if ((PROBE_REP >> (i)) & 1) { SEAM(); if ((i) == 2) { if (blockIdx.x == 0 && threadIdx.x == 0) *(unsigned*)(p.ws + WS_CTR) = 0u; SEAM(); } __VA_ARGS__ } }
    RUN_PHASE(0, phase0(p, shm);)
    RUN_PHASE(1, { pg8::Gemm g{(const bf16_t*)(p.ws + WS_A1), (const bf16_t*)(p.ws + WS_BT1), MROWS, NPROJ, DM, DM};
        pg8::StaticOrder S; S.init(MROWS, NPROJ, (int)gridDim.x, (int)blockIdx.x);
        EpiProj E{(bf16_t*)(p.ws + WS_PROJ), p.lb_logits};
        pg8::gemm_phase<EpiProj, pg8::StaticOrder, false>((PG8_LAS unsigned char*)shm, g, S, E, nullptr); })
    RUN_PHASE(2, phase2(p, shm);)
    RUN_PHASE(4, {
        { pg8::Gemm g{(const bf16_t*)(p.ws + WS_MIX), (const bf16_t*)(p.ws + WS_BT2), PROWS, DM, DMIX, DMIX};
          pg8::StaticOrder S; S.init(PROWS, DM, (int)gridDim.x, (int)blockIdx.x);
          EpiRes E{(float*)(p.ws + WS_H), DM, p.x_prompt};
          pg8::gemm_phase<EpiRes, pg8::StaticOrder, false>((PG8_LAS unsigned char*)shm, g, S, E, nullptr); }
        for (int q = blockIdx.x; q < 256; q += gridDim.x) { const int kp = q & 7, tile = q >> 3;
          __syncthreads();
          pg8::Gemm g{(const bf16_t*)(p.ws + WS_MIX) + (size_t)PROWS * DMIX + kp * 512, (const bf16_t*)(p.ws + WS_BT2) + kp * 512, SROWS, DM, 512, DMIX};
          OneUnit S{tile >> 3, tile & 7};
          pg8::EpiF32 E{(float*)(p.ws + WS_HPART) + (size_t)kp * SROWS * DM, DM, nullptr};
          pg8::gemm_phase<pg8::EpiF32, OneUnit, false>((PG8_LAS unsigned char*)shm, g, S, E, nullptr); } })
    RUN_PHASE(5, phase5(p, shm);)
#ifdef PROBE_SYNC
    for (int i = 0; i < PROBE_SYNC; ++i) SEAM();
#endif
#undef RUN_PHASE
}

#ifndef N_LAUNCHES
#define N_LAUNCHES 1
#endif
extern "C" void kernel_launch(void* const* d_in, const int* in_sizes, int n_in, void* d_out, int out_size, void* d_ws, size_t ws_size, hipStream_t stream) {
    static int grid = 0;
    if (grid == 0) {
        if (n_in != 12 || ws_size < WS_END) { fprintf(stderr, "kernel_launch: unexpected shapes (n_in %d, ws %zu < %zu)\n", n_in, ws_size, (size_t)WS_END); grid = -1; return; }
        int dev = 0, cus = 0, per_cu = 0;
        hipGetDevice(&dev); hipDeviceGetAttribute(&cus, hipDeviceAttributeMultiprocessorCount, dev);
        if (hipFuncSetAttribute((const void*)mega, hipFuncAttributeMaxDynamicSharedMemorySize, LDS_BYTES) != hipSuccess) { fprintf(stderr, "kernel_launch: hipFuncSetAttribute failed\n"); grid = -1; return; }
        if (hipOccupancyMaxActiveBlocksPerMultiprocessor(&per_cu, (const void*)mega, 512, LDS_BYTES) != hipSuccess || per_cu < 1) { fprintf(stderr, "kernel_launch: occupancy query says %d\n", per_cu); per_cu = 1; }
        (void)hipGetLastError();
        grid = cus * 1;
        if (grid <= 0) grid = 256;
    }
    if (grid < 0) return;
    Params p{};
    p.x_prompt = (const float*)d_in[0]; p.x_sample = (const float*)d_in[1]; p.state_conv = (const float*)d_in[2]; p.state_hgrn = (const float*)d_in[3];
    p.w_in = (const float*)d_in[4]; p.conv_w = (const float*)d_in[5]; p.norm_a = (const float*)d_in[6]; p.lb_logits = (const float*)d_in[7]; p.norm_b = (const float*)d_in[8];
    p.w_out = (const float*)d_in[9]; p.ln_gain = (const float*)d_in[10]; p.ln_bias = (const float*)d_in[11];
    p.out = (float*)d_out; p.ws = (unsigned char*)d_ws;
    (void)hipMemsetAsync((unsigned char*)d_ws + WS_CTR, 0, WS_END - WS_CTR, stream);
#if N_LAUNCHES == 1
    p.ph_lo = 0; p.ph_hi = 6;
    void* args[] = {&p};
    hipError_t e = hipLaunchCooperativeKernel((const void*)mega, dim3(grid), dim3(512), args, LDS_BYTES, stream);
    if (e != hipSuccess) fprintf(stderr, "cooperative launch failed: %s (grid %d)\n", hipGetErrorString(e), grid);
#else
    for (int i = 0; i < 6; ++i) { p.ph_lo = i; p.ph_hi = i + 1; hipLaunchKernelGGL(mega, dim3(grid), dim3(512), LDS_BYTES, stream, p); }
#endif
}
```

```cpp
#include <hip/hip_runtime.h>
namespace pg8 {
#define PG8_LAS __attribute__((address_space(3)))
typedef unsigned short bf16_t;
typedef short bf16x8 __attribute__((ext_vector_type(8)));
typedef float f32x4 __attribute__((ext_vector_type(4)));
typedef unsigned u32x4 __attribute__((ext_vector_type(4)));
constexpr int BM = 256, BK = 64, HALF = 128, HTB = HALF * BK * 2  , STAGE_BYTES = 8 * HTB, NXCD = 8, WGM = 8;

__host__ __device__ __forceinline__ int lds_byte(int r, int c) { const int st = (r >> 4) * 2 + (c >> 5), rr = r & 15, cc = c & 31, ob = rr * 64 + cc * 2; return st * 1024 + (ob ^ (((ob >> 9) & 1) << 5)); }
__host__ __device__ __forceinline__ void stage_rc(int b, int& R, int& C) { const int st = b / 1024, sb = b % 1024, swz = sb ^ (((sb >> 9) & 1) << 5); R = (st >> 1) * 16 + swz / 64; C = (st & 1) * 32 + (swz % 64) / 2; }
__host__ __device__ __forceinline__ int perm32(int rho) { const int n = rho >> 4, i = rho & 15; return 8 * (i >> 2) + 4 * n + (i & 3); }

struct Unit { int pm, pn; };
struct Gemm { const bf16_t* A; const bf16_t* Bt; int M, N, K, ld; };

struct StaticOrder {
    int nM, nN, nwg, G, c;
    __host__ __device__ void init(int M, int N, int G_, int c_) { nM = M / BM; nN = N / BM; nwg = nM * nN; G = G_; c = c_; }
    __host__ __device__ bool next(int i, Unit& u) const {
        const long L = (long)i * G + c; if (L >= nwg) return false;
        int wgid = (int)L; { const int q = nwg / NXCD, r = nwg % NXCD, xcd = wgid % NXCD, off = wgid / NXCD; wgid = (xcd < r ? xcd * (q + 1) : r * (q + 1) + (xcd - r) * q) + off; }
        const int nig = WGM * nN, gid = wgid / nig, fm = gid * WGM, gsz = (nM - fm) < WGM ? (nM - fm) : WGM;
        u.pm = fm + ((wgid % nig) % gsz); u.pn = (wgid % nig) / gsz; return true;
    }
    __device__ __forceinline__ void a_ready(const Unit&) const {}
    __device__ __forceinline__ void done(const Unit&) const {}
};
__device__ __forceinline__ unsigned cvt_pk_bf16(float lo, float hi) { unsigned r; asm volatile("v_cvt_pk_bf16_f32 %0, %1, %2" : "=v"(r) : "v"(lo), "v"(hi)); return r; }
typedef float f32x2 __attribute__((ext_vector_type(2)));
__device__ __forceinline__ f32x2 gelu_pk(f32x2 v) {
    const f32x2 av = __builtin_elementwise_abs(v), d = av * 0.2316418882f + 1.0f;
    f32x2 t; t.x = __builtin_amdgcn_rcpf(d.x); t.y = __builtin_amdgcn_rcpf(d.y);
    f32x2 q = t * 0.5307027145f + (-0.7265760135f); q = q * t + 0.7107068705f; q = q * t + (-0.142248368f); q = q * t + 0.127414796f; q = q * t;
    const f32x2 s = (v * v) * (-0.72134752044f);
    f32x2 e; e.x = __builtin_amdgcn_exp2f(s.x); e.y = __builtin_amdgcn_exp2f(s.y);
    const f32x2 m = v * (q * e), r = v - m;
    f32x2 o; o.x = v.x < 0.f ? m.x : r.x; o.y = v.y < 0.f ? m.y : r.y; return o;
}

struct EpiF32 {
    static constexpr bool PERM = false, AFTER_DRAIN = false;
    float* C; int ldc; const float* bias;
    __device__ __forceinline__ void operator()(const f32x4 (&acc)[2][2][4][2], const Unit& u, int wr, int wc, int fr, int fq) const {
        const int row0 = u.pm * BM + wr * 64 + fr, col0 = u.pn * BM + wc * 32 + 4 * fq;
        f32x4 bv[2][2];
#pragma unroll
        for (int bj = 0; bj < 2; ++bj)
#pragma unroll
            for (int n = 0; n < 2; ++n) bv[bj][n] = bias ? *(const f32x4*)(bias + col0 + bj * HALF + n * 16) : (f32x4){0.f, 0.f, 0.f, 0.f};
#pragma unroll
        for (int ai = 0; ai < 2; ++ai)
#pragma unroll
            for (int m = 0; m < 4; ++m) { float* rowp = C + (size_t)(row0 + ai * HALF + m * 16) * ldc + col0;
#pragma unroll
                for (int bj = 0; bj < 2; ++bj)
#pragma unroll
                    for (int n = 0; n < 2; ++n) *(f32x4*)(rowp + bj * HALF + n * 16) = acc[ai][bj][m][n] + bv[bj][n]; }
    }
};
template <int ACT  > struct EpiBf16 {
    static constexpr bool PERM = true, AFTER_DRAIN = false;
    bf16_t* O; int ldc; const float* bias; int split_cols; size_t split_stride;
    __device__ __forceinline__ void operator()(const f32x4 (&acc)[2][2][4][2], const Unit& u, int wr, int wc, int fr, int fq) const {
        const int row0 = u.pm * BM + wr * 64 + fr; int colt = u.pn * BM; bf16_t* base = O;
        if (split_cols) { const int t = colt / split_cols; base += (size_t)t * split_stride; colt -= t * split_cols; }
        const int col0 = colt + wc * 32 + 8 * fq, bcol0 = u.pn * BM + wc * 32 + 8 * fq;
        f32x4 bv[2][2];
#pragma unroll
        for (int bj = 0; bj < 2; ++bj)
#pragma unroll
            for (int n = 0; n < 2; ++n) bv[bj][n] = bias ? *(const f32x4*)(bias + bcol0 + bj * HALF + 4 * n) : (f32x4){0.f, 0.f, 0.f, 0.f};
#pragma unroll
        for (int ai = 0; ai < 2; ++ai)
#pragma unroll
            for (int m = 0; m < 4; ++m) { bf16_t* rowp = base + (size_t)(row0 + ai * HALF + m * 16) * ldc + col0;
#pragma unroll
                for (int bj = 0; bj < 2; ++bj) { f32x4 v0 = acc[ai][bj][m][0] + bv[bj][0], v1 = acc[ai][bj][m][1] + bv[bj][1];
                    if (ACT == 1) { f32x2 a = gelu_pk((f32x2){v0[0], v0[1]}), b = gelu_pk((f32x2){v0[2], v0[3]}), c = gelu_pk((f32x2){v1[0], v1[1]}), d = gelu_pk((f32x2){v1[2], v1[3]});
                        v0 = (f32x4){a.x, a.y, b.x, b.y}; v1 = (f32x4){c.x, c.y, d.x, d.y}; }
                    if (ACT == 2) {
#pragma unroll
                        for (int j = 0; j < 4; ++j) { v0[j] = 0.5f * v0[j] * (1.0f + erff(v0[j] * 0.70710678f)); v1[j] = 0.5f * v1[j] * (1.0f + erff(v1[j] * 0.70710678f)); } }
                    u32x4 w; w.x = cvt_pk_bf16(v0[0], v0[1]); w.y = cvt_pk_bf16(v0[2], v0[3]); w.z = cvt_pk_bf16(v1[0], v1[1]); w.w = cvt_pk_bf16(v1[2], v1[3]);
                    *(u32x4*)(rowp + bj * HALF) = w; } }
    }
};

template <class Epi, class Sched, bool STAMP = false>
__device__ __forceinline__ void gemm_phase(PG8_LAS unsigned char* lds, const Gemm g, const Sched& S, const Epi& E, unsigned long long* stamps) {
    const int tid = threadIdx.x, wid = __builtin_amdgcn_readfirstlane(tid >> 6), lane = tid & 63, wr = wid >> 2, wc = wid & 3, fr = lane & 15, fq = lane >> 4;
    const int K = g.ld, nt = g.K / BK;
    int ts_lo = 0, ts_hi = 0, nts = 0; const unsigned long long rt_entry = STAMP ? (unsigned long long)wall_clock64() : 0ull;
#define PG8_STAMP() do { if (STAMP && wid == 0 && nts < 64) { const unsigned long long _c = (unsigned long long)clock64(); \
        ts_lo = (lane == nts) ? (int)(unsigned)_c : ts_lo; ts_hi = (lane == nts) ? (int)(unsigned)(_c >> 32) : ts_hi; ++nts; } } while (0)
    PG8_STAMP();
    unsigned voffA[2], voffB[2];
#pragma unroll
    for (int i = 0; i < 2; ++i) { int R, C; stage_rc(tid * 16 + i * 8192, R, C); const int Rb = Epi::PERM ? ((R & ~31) + perm32(R & 31)) : R;
        voffA[i] = (unsigned)(R * K + C) * 2u; voffB[i] = (unsigned)(Rb * K + C) * 2u; }
    const size_t kstep = (size_t)(BK * 2);
    const size_t hstep = (size_t)HALF * K * 2;
    const size_t tstep = 2 * hstep;
    const unsigned ldsw = (unsigned)wid * 1024u;
    const int aoff = lds_byte(wr * 64 + fr, fq * 8), boff = lds_byte(wc * 32 + fr, fq * 8);
#define PG8_SA(b, h) (((b) * 2 + (h)) * HTB)
#define PG8_SB(b, h) ((4 + (b) * 2 + (h)) * HTB)
#define PG8_STAGE(bufoff, gbase, voff) do { _Pragma("unroll") for (int _i = 0; _i < 2; ++_i) \
        __builtin_amdgcn_global_load_lds((const unsigned*)((const char*)(gbase) + (voff)[_i]), (PG8_LAS unsigned*)(lds + (bufoff) + ldsw + _i * 8192), 16, 0, 0); } while (0)
#define PG8_LDA(dst, b, h) do { _Pragma("unroll") for (int m = 0; m < 4; ++m) _Pragma("unroll") for (int k = 0; k < 2; ++k) dst[m][k] = *(const PG8_LAS bf16x8*)(lds + PG8_SA(b, h) + aoff + m * 2048 + k * 1024); } while (0)
#define PG8_LDB(dst, b, h) do { _Pragma("unroll") for (int n = 0; n < 2; ++n) _Pragma("unroll") for (int k = 0; k < 2; ++k) dst[n][k] = *(const PG8_LAS bf16x8*)(lds + PG8_SB(b, h) + boff + n * 2048 + k * 1024); } while (0)
#define PG8_MMA(ai, bj, At, Bt) do { __builtin_amdgcn_s_setprio(1); _Pragma("unroll") for (int m = 0; m < 4; ++m) _Pragma("unroll") for (int n = 0; n < 2; ++n) _Pragma("unroll") for (int k = 0; k < 2; ++k) \
        acc[ai][bj][m][n] = __builtin_amdgcn_mfma_f32_16x16x32_bf16(Bt[n][k], At[m][k], acc[ai][bj][m][n], 0, 0, 0); __builtin_amdgcn_s_setprio(0); } while (0)
#define PG8_WAIT_V(n) asm volatile("s_waitcnt vmcnt(" #n ")" ::: "memory")
#define PG8_WAIT_L(n) asm volatile("s_waitcnt lgkmcnt(" #n ")" ::: "memory")
#define PG8_BAR __builtin_amdgcn_s_barrier()
#define PG8_SCHED __builtin_amdgcn_sched_barrier(0)
    Unit cur, nxt; int ui = 0;
    if (!S.next(0, cur)) return;
    f32x4 acc[2][2][4][2];
#pragma unroll
    for (int a = 0; a < 2; ++a)
#pragma unroll
        for (int b = 0; b < 2; ++b)
#pragma unroll
            for (int m = 0; m < 4; ++m)
#pragma unroll
                for (int n = 0; n < 2; ++n) acc[a][b][m][n] = (f32x4){0.f, 0.f, 0.f, 0.f};
    bf16x8 At[4][2], B0[2][2], B1[2][2];
    const char* cA = (const char*)g.A + (size_t)cur.pm * tstep; const char* cB = (const char*)g.Bt + (size_t)cur.pn * tstep;
    S.a_ready(cur);
    PG8_STAGE(PG8_SB(0, 0), cB, voffB); PG8_STAGE(PG8_SA(0, 0), cA, voffA); PG8_STAGE(PG8_SB(0, 1), cB + hstep, voffB); PG8_STAGE(PG8_SA(0, 1), cA + hstep, voffA);
    if (wr == 1) PG8_BAR;
    PG8_WAIT_V(4); PG8_BAR;
    PG8_STAGE(PG8_SB(1, 0), cB + kstep, voffB); PG8_STAGE(PG8_SA(1, 0), cA + kstep, voffA); PG8_STAGE(PG8_SB(1, 1), cB + hstep + kstep, voffB);
    PG8_WAIT_V(6); PG8_BAR;
    PG8_STAMP();
    for (;;) {
        const bool has_next = S.next(ui + 1, nxt);
        const char* nA = has_next ? (const char*)g.A + (size_t)nxt.pm * tstep : cA; const char* nB = has_next ? (const char*)g.Bt + (size_t)nxt.pn * tstep : cB;
        for (int t = 0; t < nt; t += 2) {
            const bool last = (t == nt - 2);
            const char* a1 = cA + (size_t)(t + 1) * kstep;
            const char* a2 = last ? nA : cA + (size_t)(t + 2) * kstep; const char* b2 = last ? nB : cB + (size_t)(t + 2) * kstep;
            const char* a3 = a2 + kstep; const char* b3 = b2 + kstep;
            if (last && has_next) S.a_ready(nxt);
            PG8_LDB(B0, 0, 0); PG8_SCHED; PG8_LDA(At, 0, 0); PG8_STAGE(PG8_SA(1, 1), a1 + hstep, voffA);
            PG8_WAIT_L(8); PG8_BAR; PG8_WAIT_L(0); PG8_MMA(0, 0, At, B0); PG8_BAR; PG8_SCHED;
            PG8_LDB(B1, 0, 1); PG8_STAGE(PG8_SB(0, 0), b2, voffB);
            PG8_BAR; PG8_WAIT_L(0); PG8_MMA(0, 1, At, B1); PG8_BAR;
            PG8_LDA(At, 0, 1); PG8_STAGE(PG8_SA(0, 0), a2, voffA);
            PG8_BAR; PG8_WAIT_L(0); PG8_MMA(1, 0, At, B0); PG8_BAR; PG8_SCHED;
            PG8_STAGE(PG8_SB(0, 1), b2 + hstep, voffB);
            PG8_WAIT_V(6); PG8_BAR; PG8_MMA(1, 1, At, B1); PG8_BAR;
            PG8_LDB(B0, 1, 0); PG8_SCHED; PG8_LDA(At, 1, 0); PG8_STAGE(PG8_SA(0, 1), a2 + hstep, voffA);
            PG8_WAIT_L(8); PG8_BAR; PG8_WAIT_L(0); PG8_MMA(0, 0, At, B0); PG8_BAR; PG8_SCHED;
            PG8_LDB(B1, 1, 1); PG8_STAGE(PG8_SB(1, 0), b3, voffB);
            PG8_BAR; PG8_WAIT_L(0); PG8_MMA(0, 1, At, B1); PG8_BAR;
            PG8_LDA(At, 1, 1); PG8_STAGE(PG8_SA(1, 0), a3, voffA);
            PG8_BAR; PG8_WAIT_L(0); PG8_MMA(1, 0, At, B0); PG8_BAR; PG8_SCHED;
            PG8_STAGE(PG8_SB(1, 1), b3 + hstep, voffB);
            PG8_WAIT_V(6); PG8_BAR; PG8_MMA(1, 1, At, B1); PG8_BAR;
        }
        PG8_STAMP();
        if constexpr (!Epi::AFTER_DRAIN) { E(acc, cur, wr, wc, fr, fq); S.done(cur); }
        PG8_STAMP();
        if (!has_next) break;
#pragma unroll
        for (int a = 0; a < 2; ++a)
#pragma unroll
            for (int b = 0; b < 2; ++b)
#pragma unroll
                for (int m = 0; m < 4; ++m)
#pragma unroll
                    for (int n = 0; n < 2; ++n) acc[a][b][m][n] = (f32x4){0.f, 0.f, 0.f, 0.f};
        cur = nxt; cA = nA; cB = nB; ++ui;
    }
    PG8_WAIT_V(0);
    if (wr == 0) PG8_BAR;
    PG8_BAR;
    if constexpr (Epi::AFTER_DRAIN) { E.fused(acc, cur, wr, wc, fr, fq, lds, wid, lane); S.done(cur); }
    PG8_STAMP();
    if (STAMP && wid == 0) { stamps[lane] = lane < nts ? (((unsigned long long)(unsigned)ts_hi << 32) | (unsigned)ts_lo) : 0ull;
        if (lane == 62) stamps[62] = rt_entry; if (lane == 63) stamps[63] = (unsigned long long)wall_clock64(); }
#undef PG8_STAMP
#undef PG8_SA
#undef PG8_SB
#undef PG8_STAGE
#undef PG8_LDA
#undef PG8_LDB
#undef PG8_MMA
#undef PG8_WAIT_V
#undef PG8_WAIT_L
#undef PG8_BAR
#undef PG8_SCHED
}
}

#include <cstdio>
#include <ctime>
#include <cstdlib>
#include <cstring>
#include <cmath>
#include <vector>
#include <algorithm>
#define CK(x) do { hipError_t e_ = (x); if (e_ != hipSuccess) { fprintf(stderr, "HIP %s:%d %s\n", __FILE__, __LINE__, hipGetErrorString(e_)); exit(2); } } while (0)
#include <hip/hip_cooperative_groups.h>
#include <cstdio>
namespace cg = cooperative_groups;
using pg8::bf16_t;
typedef float f32x2_t __attribute__((ext_vector_type(2)));
typedef unsigned u32x2_t __attribute__((ext_vector_type(2)));
typedef __bf16 bf16x2_t __attribute__((ext_vector_type(2)));
__device__ __forceinline__ unsigned pkbf(float lo, float hi) { const f32x2_t v = {lo, hi}; const bf16x2_t r = __builtin_convertvector(v, bf16x2_t); return __builtin_bit_cast(unsigned, r); }

constexpr int DM = 2048, NPROJ = 16384, DMIX = 4096;
constexpr int PROWS = 8192, SROWS = 1024, MROWS = 9216;
constexpr int LDS_STAGE = 131072, LDS_BYTES = LDS_STAGE + 64;
constexpr float EPSV = 1e-5f;
constexpr float ALPHA = 1.189207115002721f;
constexpr float QSCALE = 0.08838834764831845f;

constexpr size_t WS_A1 = 0;
constexpr size_t WS_BT1 = WS_A1 + (size_t)MROWS * DM * 2;
constexpr size_t WS_O = 0;
constexpr size_t WS_BT2 = WS_BT1 + (size_t)NPROJ * DM * 2;
constexpr size_t WS_PROJ = WS_BT2 + (size_t)DM * DMIX * 2;
constexpr size_t WS_H = WS_PROJ;
constexpr size_t WS_HPART = WS_H + (size_t)MROWS * DM * 4;
constexpr size_t WS_MIX = WS_PROJ + (size_t)MROWS * NPROJ * 2;
constexpr size_t WS_CTR = WS_MIX + (size_t)MROWS * DMIX * 2;
constexpr size_t WS_BAR = WS_CTR + 256;
constexpr size_t WS_END = WS_BAR + 3456 * 4;

constexpr size_t OFF_Y = 0;
constexpr size_t OFF_NCP = (size_t)MROWS * DM;
constexpr size_t OFF_NHP = OFF_NCP + 4 * 2 * 2048;
constexpr size_t OFF_NCS = OFF_NHP + (size_t)4 * 16 * 128 * 128;
constexpr size_t OFF_NHS = OFF_NCS + (size_t)128 * 2 * 2048;

struct Params {
    const float* x_prompt; const float* x_sample; const float* state_conv; const float* state_hgrn;
    const float* w_in; const float* conv_w; const float* norm_a; const float* lb_logits; const float* norm_b;
    const float* w_out; const float* ln_gain; const float* ln_bias;
    float* out; unsigned char* ws;
    int ph_lo, ph_hi;
};

__device__ __forceinline__ float bflo(unsigned u) { return __uint_as_float(u << 16); }
__device__ __forceinline__ float bfhi(unsigned u) { return __uint_as_float(u & 0xffff0000u); }
__device__ __forceinline__ void unpack8(const uint4 r, float (&f)[8]) {
    f[0] = bflo(r.x); f[1] = bfhi(r.x); f[2] = bflo(r.y); f[3] = bfhi(r.y); f[4] = bflo(r.z); f[5] = bfhi(r.z); f[6] = bflo(r.w); f[7] = bfhi(r.w);
}
__device__ __forceinline__ uint4 pack8(const float (&f)[8]) {
    uint4 r; r.x = pkbf(f[0], f[1]); r.y = pkbf(f[2], f[3]); r.z = pkbf(f[4], f[5]); r.w = pkbf(f[6], f[7]); return r;
}
__device__ __forceinline__ uint4 ntl16(const void* p) { const pg8::u32x4 t = __builtin_nontemporal_load((const pg8::u32x4*)p); return make_uint4(t.x, t.y, t.z, t.w); }
__device__ __forceinline__ float sigm(float x) { return 1.0f / (1.0f + __expf(-x)); }
__device__ __forceinline__ float silu(float x) { return x / (1.0f + __expf(-x)); }
__device__ __forceinline__ void lds_barrier() { asm volatile("s_waitcnt lgkmcnt(0)" ::: "memory"); __builtin_amdgcn_s_barrier(); asm volatile("" ::: "memory"); }
#define DPP_ROR(x, n) __builtin_bit_cast(float, __builtin_amdgcn_update_dpp(0, __builtin_bit_cast(int, (x)), 0x120 + (n), 0xF, 0xF, true))
__device__ __forceinline__ float row16_sum(float x) { x += DPP_ROR(x, 8); x += DPP_ROR(x, 4); x += DPP_ROR(x, 2); x += DPP_ROR(x, 1); return x; }


typedef _Float16 h16x2 __attribute__((ext_vector_type(2)));
__device__ __forceinline__ unsigned pack_h2(float a, float b) { const h16x2 v = {(_Float16)a, (_Float16)b}; return __builtin_bit_cast(unsigned, v); }
__device__ __forceinline__ float h2lo(unsigned u) { return (float)__builtin_bit_cast(h16x2, u)[0]; }
__device__ __forceinline__ float h2hi(unsigned u) { return (float)__builtin_bit_cast(h16x2, u)[1]; }
__device__ __forceinline__ float ex2(float x) { return __builtin_amdgcn_exp2f(x); }

struct EpiProj {
    static constexpr bool PERM = true, AFTER_DRAIN = false;
    bf16_t* O; const float* lbl;
    __device__ __forceinline__ void operator()(const pg8::f32x4 (&acc)[2][2][4][2], const pg8::Unit& u, int wr, int wc, int fr, int fq) const {
        using namespace pg8;
        const int row0 = u.pm * BM + wr * 64 + fr, seg = u.pn >> 3, col0 = u.pn * BM + wc * 32 + 8 * fq;
        if (seg == 5) {
            float lb[2][8];
#pragma unroll
            for (int bj = 0; bj < 2; ++bj) { const float* l0 = lbl + (col0 - 5 * 2048) + bj * HALF; const float* l1 = l0 + 2048;
                const f32x4 a0 = *(const f32x4*)l0, a1 = *(const f32x4*)(l0 + 4), b0 = *(const f32x4*)l1, b1 = *(const f32x4*)(l1 + 4);
#pragma unroll
                for (int j = 0; j < 4; ++j) { lb[bj][j] = 1.0f / (1.0f + __expf(b0[j] - a0[j])); lb[bj][4 + j] = 1.0f / (1.0f + __expf(b1[j] - a1[j])); } }
#pragma unroll
            for (int ai = 0; ai < 2; ++ai)
#pragma unroll
                for (int m = 0; m < 4; ++m) { const size_t row = (size_t)(row0 + ai * HALF + m * 16);
#pragma unroll
                    for (int bj = 0; bj < 2; ++bj) { const f32x4 v0 = acc[ai][bj][m][0], v1 = acc[ai][bj][m][1];
                        float g[8];
#pragma unroll
                        for (int j = 0; j < 4; ++j) { g[j] = lb[bj][j] + (1.0f - lb[bj][j]) * sigm(v0[j]); g[4 + j] = lb[bj][4 + j] + (1.0f - lb[bj][4 + j]) * sigm(v1[j]); }
                        u32x4 wg; wg.x = pack_h2(g[0], g[1]); wg.y = pack_h2(g[2], g[3]); wg.z = pack_h2(g[4], g[5]); wg.w = pack_h2(g[6], g[7]);
                        *(u32x4*)(O + row * NPROJ + col0 + bj * HALF) = wg; } }
        } else {
            const bool act = (seg == 3) | (seg == 4) | (seg == 7); const float sc = seg == 4 ? QSCALE : 1.0f;
#pragma unroll
            for (int ai = 0; ai < 2; ++ai)
#pragma unroll
                for (int m = 0; m < 4; ++m) { bf16_t* rowp = O + (size_t)(row0 + ai * HALF + m * 16) * NPROJ + col0;
#pragma unroll
                    for (int bj = 0; bj < 2; ++bj) { f32x4 v0 = acc[ai][bj][m][0], v1 = acc[ai][bj][m][1];
                        if (act) {
#pragma unroll
                            for (int j = 0; j < 4; ++j) { v0[j] = silu(v0[j]) * sc; v1[j] = silu(v1[j]) * sc; } }
                        u32x4 w; w.x = pkbf(v0[0], v0[1]); w.y = pkbf(v0[2], v0[3]); w.z = pkbf(v1[0], v1[1]); w.w = pkbf(v1[2], v1[3]);
                        *(u32x4*)(rowp + bj * HALF) = w; } }
        }
    }
};

__device__ __forceinline__ void p0_tile_info(const Params& p, int tile, const float*& src, int& ld, bf16_t*& dst, int& ldd) {
    if (tile < 2048) { const int kt = tile >> 6, nt = tile & 63; src = p.w_in + (size_t)(kt * 64) * NPROJ + nt * 256; ld = NPROJ;
        dst = (bf16_t*)(p.ws + WS_BT1) + (size_t)(nt * 256) * DM + kt * 64; ldd = DM; }
    else { const int t2 = tile - 2048, kt = t2 >> 3, nt = t2 & 7; src = p.w_out + (size_t)(kt * 64) * DM + nt * 256; ld = DM;
        dst = (bf16_t*)(p.ws + WS_BT2) + (size_t)(nt * 256) * DMIX + kt * 64; ldd = DMIX; }
}
__device__ void phase0(const Params& p, unsigned char* lds) {
    float* T = (float*)lds;
    const int tid = threadIdx.x;
    if (blockIdx.x == 0 && tid == 0) *(unsigned*)(p.ws + WS_CTR) = 0u;
    constexpr int NT = 2048 + 512;
    pg8::f32x4 r[8];
    int tile = blockIdx.x;
    const float* src = nullptr; int ld = 0; bf16_t* dst = nullptr; int ldd = 0;
    p0_tile_info(p, tile < NT ? tile : NT - 1, src, ld, dst, ldd);
#pragma unroll
    for (int i = 0; i < 8; ++i) r[i] = __builtin_nontemporal_load((const pg8::f32x4*)(src + (size_t)(i * 8 + (tid >> 6)) * ld + (tid & 63) * 4));
    while (tile < NT) {
#pragma unroll
        for (int i = 0; i < 8; ++i) { const int k = i * 8 + (tid >> 6), n = (tid & 63) * 4; *(pg8::f32x4*)&T[k * 256 + (n ^ (i << 3))] = r[i]; }
        bf16_t* cdst = dst; const int cldd = ldd;
        const int nxt = tile + gridDim.x;
        p0_tile_info(p, nxt < NT ? nxt : NT - 1, src, ld, dst, ldd);
#pragma unroll
        for (int i = 0; i < 8; ++i) r[i] = __builtin_nontemporal_load((const pg8::f32x4*)(src + (size_t)(i * 8 + (tid >> 6)) * ld + (tid & 63) * 4));
        lds_barrier();
#pragma unroll
        for (int c = 0; c < 4; ++c) { const int q = tid + 512 * c, n = q >> 3, k8 = q & 7; float v[8];
#pragma unroll
            for (int j = 0; j < 8; ++j) v[j] = T[(k8 * 8 + j) * 256 + (n ^ (k8 << 3))];
            *(uint4*)(cdst + (size_t)n * cldd + k8 * 8) = pack8(v); }
        lds_barrier();
        tile = nxt;
    }
    bf16_t* A1 = (bf16_t*)(p.ws + WS_A1);
    constexpr size_t total8 = (size_t)MROWS * DM / 8, pe = (size_t)PROWS * DM;
    const size_t stride = (size_t)gridDim.x * 512;
    for (size_t i = (size_t)blockIdx.x * 512 + tid; i < total8; i += 3 * stride) {
        const size_t i0 = i, i1 = i + stride, i2 = i + 2 * stride;
        const size_t j1 = i1 < total8 ? i1 : i0, j2 = i2 < total8 ? i2 : i0;
        const size_t e0 = i0 * 8, e1 = j1 * 8, e2 = j2 * 8;
        const float* s0 = e0 < pe ? p.x_prompt + e0 : p.x_sample + (e0 - pe);
        const float* s1 = e1 < pe ? p.x_prompt + e1 : p.x_sample + (e1 - pe);
        const float* s2 = e2 < pe ? p.x_prompt + e2 : p.x_sample + (e2 - pe);
        const pg8::f32x4 a0 = __builtin_nontemporal_load((const pg8::f32x4*)s0), b0 = __builtin_nontemporal_load((const pg8::f32x4*)(s0 + 4)), a1 = __builtin_nontemporal_load((const pg8::f32x4*)s1), b1 = __builtin_nontemporal_load((const pg8::f32x4*)(s1 + 4)), a2 = __builtin_nontemporal_load((const pg8::f32x4*)s2), b2 = __builtin_nontemporal_load((const pg8::f32x4*)(s2 + 4));
        { const float v[8] = {a0.x, a0.y, a0.z, a0.w, b0.x, b0.y, b0.z, b0.w}; *(uint4*)(A1 + e0) = pack8(v); }
        if (i1 < total8) { const float v[8] = {a1.x, a1.y, a1.z, a1.w, b1.x, b1.y, b1.z, b1.w}; *(uint4*)(A1 + e1) = pack8(v); }
        if (i2 < total8) { const float v[8] = {a2.x, a2.y, a2.z, a2.w, b2.x, b2.y, b2.z, b2.w}; *(uint4*)(A1 + e2) = pack8(v); }
    }
}

__device__ __forceinline__ pg8::bf16x8 ldfrag(const unsigned char* p) { const uint4 r = *(const uint4*)p; return __builtin_bit_cast(pg8::bf16x8, r); }
__device__ void hgrn_prompt_item(const Params& p, unsigned char* lds, int it) {
    using pg8::bf16x8; using pg8::f32x4;
    const int h = it & 15, b = it >> 4;
    unsigned char* QE = lds; unsigned char* KE = lds + 18432; unsigned char* KTT = lds + 36864; unsigned char* VT = lds + 57344;
    float* TOT = (float*)(lds + 77824); float* DL = (float*)(lds + 81920); float* OB = (float*)(lds + 82432);
    int tid = threadIdx.x; asm volatile("" : "+v"(tid));
    const int lane = tid & 63, w = tid >> 6, fr = lane & 15, kq = lane >> 4;
    const size_t row0 = (size_t)b * 2048;
    bf16_t* mix = (bf16_t*)(p.ws + WS_MIX);
    const char* pbase = (const char*)(p.ws + WS_PROJ) + (row0 * NPROJ + 4 * 2048 + h * 128) * 2;
    const int m16 = lane & 15;
    const int qoff = (32 * (lane >> 4) + 8 * ((m16 & 7) >> 1) + 4 * (m16 >> 3) + 2 * (m16 & 1)) * 2;
    const int sc0 = ((4 * (w >> 2) + 2 * (w & 1)) ^ (lane & 7)) * 16 + 8 * ((w >> 1) & 1), sc1 = ((4 * (w >> 2) + 2 * (w & 1) + 1) ^ (lane & 7)) * 16 + 8 * ((w >> 1) & 1);
    const unsigned voff = (unsigned)((8 * w * NPROJ + 2 * lane) * 2);
    unsigned rq[8], rf[8], rv[8];
#define HG_PF(c) do { const char* cb = pbase + (size_t)(c) * 64 * NPROJ * 2; _Pragma("unroll") for (int i = 0; i < 8; ++i) { const char* ri = cb + (size_t)i * NPROJ * 2; \
        rq[i] = *(const unsigned*)(ri + voff); rf[i] = *(const unsigned*)(ri + 4096 + voff); rv[i] = *(const unsigned*)(ri + 8192 + voff); } } while (0)
    HG_PF(0);
    f32x4 S[8];
#pragma unroll
    for (int i = 0; i < 8; ++i) S[i] = (f32x4){0.f, 0.f, 0.f, 0.f};
    for (int c = 0; c < 32; ++c) {
        float e0[8], e1[8]; float a0 = 1.f, a1 = 1.f;
#pragma unroll
        for (int i = 0; i < 8; ++i) { a0 *= h2lo(rf[i]); a1 *= h2hi(rf[i]); e0[i] = a0; e1[i] = a1; }
        *(float2*)&TOT[w * 128 + 2 * lane] = make_float2(a0, a1);
        lds_barrier();
        float off0 = 1.f, off1 = 1.f, tot0 = 1.f, tot1 = 1.f;
#pragma unroll
        for (int ww = 0; ww < 8; ++ww) { const float2 t = *(const float2*)&TOT[ww * 128 + 2 * lane]; if (ww < w) { off0 *= t.x; off1 *= t.y; } tot0 *= t.x; tot1 *= t.y; }
        if (w == 0) *(float2*)&DL[2 * lane] = make_float2(tot0, tot1);
        float kt0[8], kt1[8];
#pragma unroll
        for (int i = 0; i < 8; ++i) { const float E0 = off0 * e0[i], E1 = off1 * e1[i];
            const float ke0 = (1.0f - h2lo(rf[i])) * __builtin_amdgcn_rcpf(E0), ke1 = (1.0f - h2hi(rf[i])) * __builtin_amdgcn_rcpf(E1);
            kt0[i] = ke0 * tot0; kt1[i] = ke1 * tot1;
            const int t = 8 * w + i;
            *(unsigned*)(QE + t * 288 + qoff) = pkbf(bflo(rq[i]) * E0, bfhi(rq[i]) * E1);
            *(unsigned*)(KE + t * 288 + qoff) = pkbf(ke0, ke1); }
        { unsigned char* r0 = KTT + (2 * lane) * 128; unsigned char* r1 = r0 + 128;
          *(uint2*)(r0 + sc0) = make_uint2(pkbf(kt0[0], kt0[1]), pkbf(kt0[2], kt0[3])); *(uint2*)(r0 + sc1) = make_uint2(pkbf(kt0[4], kt0[5]), pkbf(kt0[6], kt0[7]));
          *(uint2*)(r1 + sc0) = make_uint2(pkbf(kt1[0], kt1[1]), pkbf(kt1[2], kt1[3])); *(uint2*)(r1 + sc1) = make_uint2(pkbf(kt1[4], kt1[5]), pkbf(kt1[6], kt1[7])); }
        { unsigned char* r0 = VT + (2 * lane) * 128; unsigned char* r1 = r0 + 128;
          *(uint2*)(r0 + sc0) = make_uint2((rv[0] & 0xffffu) | (rv[1] << 16), (rv[2] & 0xffffu) | (rv[3] << 16)); *(uint2*)(r0 + sc1) = make_uint2((rv[4] & 0xffffu) | (rv[5] << 16), (rv[6] & 0xffffu) | (rv[7] << 16));
          *(uint2*)(r1 + sc0) = make_uint2((rv[0] >> 16) | (rv[1] & 0xffff0000u), (rv[2] >> 16) | (rv[3] & 0xffff0000u)); *(uint2*)(r1 + sc1) = make_uint2((rv[4] >> 16) | (rv[5] & 0xffff0000u), (rv[6] >> 16) | (rv[7] & 0xffff0000u)); }
        if (c + 1 < 32) HG_PF(c + 1);
        lds_barrier();
        uint4 rz[2]; float4 nba, nbb;
        { const int v8 = (tid & 15) * 8; const bf16_t* zp = (const bf16_t*)(pbase + (size_t)c * 64 * NPROJ * 2) + 3 * 2048 + v8;
          rz[0] = *(const uint4*)(zp + (size_t)(tid >> 4) * NPROJ); rz[1] = *(const uint4*)(zp + (size_t)(32 + (tid >> 4)) * NPROJ);
          nba = *(const float4*)(p.norm_b + h * 128 + v8); nbb = *(const float4*)(p.norm_b + h * 128 + v8 + 4); }
        bf16x8 qf[4][4], kf[2][4];
#pragma unroll
        for (int ti = 0; ti < 4; ++ti)
#pragma unroll
            for (int ks = 0; ks < 4; ++ks) qf[ti][ks] = ldfrag(QE + (16 * ti + fr) * 288 + ks * 64 + kq * 16);
#pragma unroll
        for (int ks = 0; ks < 4; ++ks) kf[0][ks] = ldfrag(KE + fr * 288 + ks * 64 + kq * 16);
        bf16x8 Sb[4];
#pragma unroll
        for (int ks = 0; ks < 4; ++ks) { const f32x4 x = S[2 * ks], y = S[2 * ks + 1];
            const uint4 r = make_uint4(pkbf(x[0], x[1]), pkbf(x[2], x[3]), pkbf(y[0], y[1]), pkbf(y[2], y[3])); Sb[ks] = __builtin_bit_cast(bf16x8, r); }
        f32x4 oacc[4];
#pragma unroll
        for (int ti = 0; ti < 4; ++ti) oacc[ti] = (f32x4){0.f, 0.f, 0.f, 0.f};
#pragma unroll
        for (int ks = 0; ks < 4; ++ks)
#pragma unroll
            for (int ti = 0; ti < 4; ++ti) oacc[ti] = __builtin_amdgcn_mfma_f32_16x16x32_bf16(qf[ti][ks], Sb[ks], oacc[ti], 0, 0, 0);
        uint2 ap[4][4];
#pragma unroll
        for (int ti = 0; ti < 4; ++ti)
#pragma unroll
            for (int si = 0; si < 4; ++si) ap[ti][si] = make_uint2(0u, 0u);
        bf16x8 vf[2], ktf[8][2]; float4 dlv[8];
#pragma unroll
        for (int si = 0; si < 4; ++si) {
            if (si < 3) {
#pragma unroll
                for (int ks = 0; ks < 4; ++ks) kf[(si + 1) & 1][ks] = ldfrag(KE + (16 * (si + 1) + fr) * 288 + ks * 64 + kq * 16); }
            else {
#pragma unroll
                for (int ss = 0; ss < 2; ++ss) vf[ss] = ldfrag(VT + (16 * w + fr) * 128 + (((4 * ss + kq) * 16) ^ (((fr >> 1) & 7) * 16)));
#pragma unroll
                for (int kt = 0; kt < 8; ++kt) dlv[kt] = *(const float4*)&DL[16 * kt + 4 * kq]; }
            f32x4 d[4];
#pragma unroll
            for (int ti = si; ti < 4; ++ti) d[ti] = (f32x4){0.f, 0.f, 0.f, 0.f};
#pragma unroll
            for (int ks = 0; ks < 4; ++ks)
#pragma unroll
                for (int ti = si; ti < 4; ++ti) d[ti] = __builtin_amdgcn_mfma_f32_16x16x32_bf16(kf[si & 1][ks], qf[ti][ks], d[ti], 0, 0, 0);
#pragma unroll
            for (int j = 0; j < 4; ++j) d[si][j] = (4 * kq + j <= fr) ? d[si][j] : 0.f;
#pragma unroll
            for (int ti = si; ti < 4; ++ti) ap[ti][si] = make_uint2(pkbf(d[ti][0], d[ti][1]), pkbf(d[ti][2], d[ti][3])); }
#pragma unroll
        for (int kt = 0; kt < 8; ++kt)
#pragma unroll
            for (int ss = 0; ss < 2; ++ss) ktf[kt][ss] = ldfrag(KTT + (16 * kt + fr) * 128 + (((4 * ss + kq) * 16) ^ (((fr >> 1) & 7) * 16)));
#pragma unroll
        for (int ti = 0; ti < 4; ++ti)
#pragma unroll
            for (int ss = 0; ss < 2; ++ss) if (2 * ss <= ti) { const uint4 r = make_uint4(ap[ti][2 * ss].x, ap[ti][2 * ss].y, ap[ti][2 * ss + 1].x, ap[ti][2 * ss + 1].y);
                oacc[ti] = __builtin_amdgcn_mfma_f32_16x16x32_bf16(__builtin_bit_cast(bf16x8, r), vf[ss], oacc[ti], 0, 0, 0); }
#pragma unroll
        for (int kt = 0; kt < 8; ++kt) { S[kt][0] *= dlv[kt].x; S[kt][1] *= dlv[kt].y; S[kt][2] *= dlv[kt].z; S[kt][3] *= dlv[kt].w; }
#pragma unroll
        for (int ss = 0; ss < 2; ++ss)
#pragma unroll
            for (int kt = 0; kt < 8; ++kt) S[kt] = __builtin_amdgcn_mfma_f32_16x16x32_bf16(ktf[kt][ss], vf[ss], S[kt], 0, 0, 0);
#pragma unroll
        for (int ti = 0; ti < 4; ++ti)
#pragma unroll
            for (int j = 0; j < 4; ++j) OB[(16 * ti + 4 * kq + j) * 128 + 16 * w + fr] = oacc[ti][j];
        lds_barrier();
#pragma unroll
        for (int ps = 0; ps < 2; ++ps) { const int t = ps * 32 + (tid >> 4), v8 = (tid & 15) * 8;
            const float4 oa = *(const float4*)&OB[t * 128 + v8], ob = *(const float4*)&OB[t * 128 + v8 + 4];
            const float o[8] = {oa.x, oa.y, oa.z, oa.w, ob.x, ob.y, ob.z, ob.w}; const float nb[8] = {nba.x, nba.y, nba.z, nba.w, nbb.x, nbb.y, nbb.z, nbb.w}; float z[8]; unpack8(rz[ps], z);
            float ss = 0.f;
#pragma unroll
            for (int j = 0; j < 8; ++j) ss += o[j] * o[j];
            ss = row16_sum(ss);
            const float sc = rsqrtf(ss * (1.0f / 128.0f) + EPSV);
            float y[8];
#pragma unroll
            for (int j = 0; j < 8; ++j) y[j] = o[j] * sc * nb[j] * z[j];
            *(uint4*)(mix + (row0 + (size_t)c * 64 + t) * DMIX + 2048 + h * 128 + v8) = pack8(y); }
    }
#undef HG_PF
    float* sd = p.out + OFF_NHP + ((size_t)(b * 16 + h) * 128 + 4 * kq) * 128 + 16 * w + fr;
#pragma unroll
    for (int kt = 0; kt < 8; ++kt)
#pragma unroll
        for (int j = 0; j < 4; ++j) sd[(size_t)(16 * kt + j) * 128] = S[kt][j];
    lds_barrier();
}

__device__ void hgrn_sample_item(const Params& p, unsigned char* lds, int it) {
    const int h = it & 15, b = it >> 4;
    float* Q = (float*)lds; float* F = Q + 1024; float* Op = F + 1024;
    int tid = threadIdx.x; asm volatile("" : "+v"(tid));
    const int lane = tid & 63, w = tid >> 6;
    const bf16_t* proj = (const bf16_t*)(p.ws + WS_PROJ);
    const size_t soff = (size_t)it * 16384 + (size_t)(16 * w) * 128 + 2 * lane;
    const float* s0 = p.state_hgrn + soff;
    float2 S[16];
#pragma unroll
    for (int j = 0; j < 16; ++j) { const f32x2_t t = __builtin_nontemporal_load((const f32x2_t*)(s0 + j * 128)); S[j] = make_float2(t.x, t.y); }
    const size_t row0 = (size_t)PROWS + (size_t)b * 8;
    float2 vv[8];
#pragma unroll
    for (int t = 0; t < 8; ++t) { const unsigned u = *(const unsigned*)(proj + (row0 + t) * NPROJ + 6 * 2048 + h * 128 + 2 * lane); vv[t] = make_float2(bflo(u), bfhi(u)); }
    if (tid < 128) { const int t = tid >> 4, pk = (tid & 15) * 8;
        const bf16_t* qp = proj + (row0 + t) * NPROJ + 4 * 2048 + h * 128 + pk;
        const uint4 rq = *(const uint4*)qp, rf = *(const uint4*)(qp + 2048);
        float q[8], f[8]; unpack8(rq, q);
        f[0] = h2lo(rf.x); f[1] = h2hi(rf.x); f[2] = h2lo(rf.y); f[3] = h2hi(rf.y); f[4] = h2lo(rf.z); f[5] = h2hi(rf.z); f[6] = h2lo(rf.w); f[7] = h2hi(rf.w);
        *(float4*)&Q[t * 128 + pk] = make_float4(q[0], q[1], q[2], q[3]); *(float4*)&Q[t * 128 + pk + 4] = make_float4(q[4], q[5], q[6], q[7]);
        *(float4*)&F[t * 128 + pk] = make_float4(f[0], f[1], f[2], f[3]); *(float4*)&F[t * 128 + pk + 4] = make_float4(f[4], f[5], f[6], f[7]); }
    lds_barrier();
#pragma unroll
    for (int t = 0; t < 8; ++t) { float2 op = make_float2(0.f, 0.f);
#pragma unroll
        for (int j4 = 0; j4 < 4; ++j4) { const float4 f4 = *(const float4*)&F[t * 128 + 16 * w + j4 * 4], q4 = *(const float4*)&Q[t * 128 + 16 * w + j4 * 4];
            const float ff[4] = {f4.x, f4.y, f4.z, f4.w}, qq[4] = {q4.x, q4.y, q4.z, q4.w};
#pragma unroll
            for (int j = 0; j < 4; ++j) { float2& s = S[j4 * 4 + j]; s.x = ff[j] * (s.x - vv[t].x) + vv[t].x; s.y = ff[j] * (s.y - vv[t].y) + vv[t].y; op.x += s.x * qq[j]; op.y += s.y * qq[j]; } }
        *(float2*)&Op[(w * 8 + t) * 128 + 2 * lane] = op; }
    float* d = p.out + OFF_NHS + soff;
#pragma unroll
    for (int j = 0; j < 16; ++j) { const f32x2_t t = {S[j].x, S[j].y}; __builtin_nontemporal_store(t, (f32x2_t*)(d + j * 128)); }
    lds_barrier();
    { const int idx = tid * 2, t = idx >> 7, v = idx & 127; float2 s = make_float2(0.f, 0.f);
#pragma unroll
      for (int ww = 0; ww < 8; ++ww) { const float2 o = *(const float2*)&Op[(ww * 8 + t) * 128 + v]; s.x += o.x; s.y += o.y; }
      float ss = row16_sum(s.x * s.x + s.y * s.y); ss += __shfl_xor(ss, 16); ss += __shfl_xor(ss, 32);
      const float sc = rsqrtf(ss * (1.0f / 128.0f) + EPSV);
      const float2 nb = *(const float2*)(p.norm_b + h * 128 + v);
      const unsigned zz = *(const unsigned*)(proj + (row0 + t) * NPROJ + 7 * 2048 + h * 128 + v);
      *(unsigned*)((bf16_t*)(p.ws + WS_MIX) + (row0 + t) * DMIX + 2048 + h * 128 + v) = pkbf(s.x * sc * nb.x * bflo(zz), s.y * sc * nb.y * bfhi(zz)); }
    lds_barrier();
}

__device__ void conv_item(const Params& p, int item) {
    int tid = threadIdx.x; asm volatile("" : "+v"(tid));
    const int half = tid >> 8, c0 = (tid & 255) * 8;
    const bf16_t* proj = (const bf16_t*)(p.ws + WS_PROJ);
    bf16_t* mix = (bf16_t*)(p.ws + WS_MIX);
    size_t row0; int t0, L, T; float* ncout; bool sample;
    if (item < 256) { const int g = item * 2 + half; row0 = (size_t)g * 16; const int b = g >> 7; t0 = (g & 127) * 16; L = 16; T = 2048; ncout = p.out + OFF_NCP + (size_t)b * 2 * 2048; sample = false; }
    else { const int s = (item - 256) * 2 + half; row0 = (size_t)PROWS + (size_t)s * 8; t0 = 0; L = 8; T = 8; ncout = p.out + OFF_NCS + (size_t)s * 2 * 2048; sample = true; }
    float w0[8], w1[8], w2[8], na[8], u1[8], u2[8];
    { const float4 a = *(const float4*)(p.conv_w + c0), b = *(const float4*)(p.conv_w + c0 + 4); w0[0] = a.x; w0[1] = a.y; w0[2] = a.z; w0[3] = a.w; w0[4] = b.x; w0[5] = b.y; w0[6] = b.z; w0[7] = b.w; }
    { const float4 a = *(const float4*)(p.conv_w + 2048 + c0), b = *(const float4*)(p.conv_w + 2048 + c0 + 4); w1[0] = a.x; w1[1] = a.y; w1[2] = a.z; w1[3] = a.w; w1[4] = b.x; w1[5] = b.y; w1[6] = b.z; w1[7] = b.w; }
    { const float4 a = *(const float4*)(p.conv_w + 4096 + c0), b = *(const float4*)(p.conv_w + 4096 + c0 + 4); w2[0] = a.x; w2[1] = a.y; w2[2] = a.z; w2[3] = a.w; w2[4] = b.x; w2[5] = b.y; w2[6] = b.z; w2[7] = b.w; }
    { const float4 a = *(const float4*)(p.norm_a + c0), b = *(const float4*)(p.norm_a + c0 + 4); na[0] = a.x; na[1] = a.y; na[2] = a.z; na[3] = a.w; na[4] = b.x; na[5] = b.y; na[6] = b.z; na[7] = b.w; }
    if (sample) { const float* sc = p.state_conv + (size_t)((item - 256) * 2 + half) * 2 * 2048 + c0;
        const float4 a = *(const float4*)sc, b = *(const float4*)(sc + 4), c = *(const float4*)(sc + 2048), d = *(const float4*)(sc + 2048 + 4);
        u2[0] = a.x; u2[1] = a.y; u2[2] = a.z; u2[3] = a.w; u2[4] = b.x; u2[5] = b.y; u2[6] = b.z; u2[7] = b.w;
        u1[0] = c.x; u1[1] = c.y; u1[2] = c.z; u1[3] = c.w; u1[4] = d.x; u1[5] = d.y; u1[6] = d.z; u1[7] = d.w; }
    else if (t0 == 0) {
#pragma unroll
        for (int j = 0; j < 8; ++j) { u1[j] = 0.f; u2[j] = 0.f; } }
    else { const bf16_t* r2 = proj + (row0 - 2) * NPROJ + c0; const bf16_t* r1 = r2 + NPROJ;
        const uint4 v2 = *(const uint4*)r2, cc2 = *(const uint4*)(r2 + 2 * 2048), v1 = *(const uint4*)r1, cc1 = *(const uint4*)(r1 + 2 * 2048);
        float a[8], b[8]; unpack8(v2, a); unpack8(cc2, b);
#pragma unroll
        for (int j = 0; j < 8; ++j) u2[j] = a[j] * b[j];
        unpack8(v1, a); unpack8(cc1, b);
#pragma unroll
        for (int j = 0; j < 8; ++j) u1[j] = a[j] * b[j]; }
    for (int tb = 0; tb < L; tb += 4) {
        uint4 rv[4], rb[4], rc[4], rz[4];
#pragma unroll
        for (int i = 0; i < 4; ++i) { const bf16_t* r = proj + (row0 + tb + i) * NPROJ + c0; rv[i] = ntl16(r); rb[i] = ntl16(r + 2048); rc[i] = ntl16(r + 4096); rz[i] = ntl16(r + 6144); }
#pragma unroll
        for (int i = 0; i < 4; ++i) {
            float v[8], bb[8], cc[8], z[8], u[8], pre[8]; unpack8(rv[i], v); unpack8(rb[i], bb); unpack8(rc[i], cc); unpack8(rz[i], z);
            float ss = 0.f;
#pragma unroll
            for (int j = 0; j < 8; ++j) { u[j] = cc[j] * v[j]; const float cv = w0[j] * u2[j] + w1[j] * u1[j] + w2[j] * u[j]; pre[j] = bb[j] * cv; ss += pre[j] * pre[j]; }
            ss = row16_sum(ss);
            const float sc = rsqrtf(ss * (1.0f / 128.0f) + EPSV);
            float y[8];
#pragma unroll
            for (int j = 0; j < 8; ++j) { y[j] = pre[j] * sc * na[j] * z[j]; u2[j] = u1[j]; u1[j] = u[j]; }
            *(uint4*)(mix + (row0 + tb + i) * DMIX + c0) = pack8(y);
            const int t = t0 + tb + i;
            if (t >= T - 2) { float* d = ncout + (size_t)(t - (T - 2)) * 2048 + c0; *(float4*)d = make_float4(u[0], u[1], u[2], u[3]); *(float4*)(d + 4) = make_float4(u[4], u[5], u[6], u[7]); }
        }
    }
}

__device__ void phase2(const Params& p, unsigned char* lds) {
    unsigned* ctr = (unsigned*)(p.ws + WS_CTR);
    volatile int* slot = (volatile int*)(lds + LDS_STAGE + 16);
    constexpr int N_ITEMS = 64 + 2048 + 320;
    const int tid = threadIdx.x;
#ifdef STATIC_QUEUE
    for (int item = blockIdx.x; item < N_ITEMS; item += gridDim.x) {
        if (item < 64) hgrn_prompt_item(p, lds, item);
        else if (item < 64 + 2048) hgrn_sample_item(p, lds, item - 64);
        else conv_item(p, item - (64 + 2048));
        lds_barrier();
    }
    return;
#endif
    const bool pin = gridDim.x >= 256;
    if (tid == 0) *slot = pin ? ((blockIdx.x < 64) ? (int)blockIdx.x : 64 + (int)atomicAdd(ctr, 1u)) : (int)atomicAdd(ctr, 1u);
    lds_barrier();
    int item = *slot;
    lds_barrier();
    while (item < N_ITEMS) {
        unsigned nxt = 0;
        if (tid == 0) nxt = (pin ? 64u : 0u) + atomicAdd(ctr, 1u);
#ifndef PROBE_ITEM
#define PROBE_ITEM 0
#endif
        const int reps_a = (PROBE_ITEM == 1 && p.ph_hi == 6) ? 2 : 1, reps_b = (PROBE_ITEM == 2 && p.ph_hi == 6) ? 2 : 1, reps_c = (PROBE_ITEM == 3 && p.ph_hi == 6) ? 2 : 1;
        if (item < 64) { for (int r = 0; r < reps_a; ++r) hgrn_prompt_item(p, lds, item); }
        else if (item < 64 + 2048) { for (int r = 0; r < reps_b; ++r) hgrn_sample_item(p, lds, item - 64); }
        else { for (int r = 0; r < reps_c; ++r) conv_item(p, item - (64 + 2048)); }
        if (tid == 0) *slot = (int)nxt;
        lds_barrier();
        item = *slot;
        lds_barrier();
    }
}

__device__ void phase3(const Params& p) {
    const int tid = threadIdx.x, half = tid >> 8, c0 = (tid & 255) * 8;
    const bf16_t* proj = (const bf16_t*)(p.ws + WS_PROJ);
    const float* ows = (const float*)(p.ws + WS_O);
    bf16_t* mix = (bf16_t*)(p.ws + WS_MIX);
    float nb[8];
    { const float4 a = *(const float4*)(p.norm_b + c0), b = *(const float4*)(p.norm_b + c0 + 4); nb[0] = a.x; nb[1] = a.y; nb[2] = a.z; nb[3] = a.w; nb[4] = b.x; nb[5] = b.y; nb[6] = b.z; nb[7] = b.w; }
    for (int base = blockIdx.x * 8; base < MROWS; base += gridDim.x * 8) {
        float4 oa[4], ob[4]; uint4 rz[4];
#pragma unroll
        for (int i = 0; i < 4; ++i) { const size_t r = (size_t)base + half * 4 + i; oa[i] = *(const float4*)(ows + r * DM + c0); ob[i] = *(const float4*)(ows + r * DM + c0 + 4); rz[i] = *(const uint4*)(proj + r * NPROJ + 7 * 2048 + c0); }
#pragma unroll
        for (int i = 0; i < 4; ++i) { const size_t r = (size_t)base + half * 4 + i;
            const float o[8] = {oa[i].x, oa[i].y, oa[i].z, oa[i].w, ob[i].x, ob[i].y, ob[i].z, ob[i].w}; float z[8]; unpack8(rz[i], z);
            float ss = 0.f;
#pragma unroll
            for (int j = 0; j < 8; ++j) ss += o[j] * o[j];
            ss = row16_sum(ss);
            const float sc = rsqrtf(ss * (1.0f / 128.0f) + EPSV);
            float y[8];
#pragma unroll
            for (int j = 0; j < 8; ++j) y[j] = o[j] * sc * nb[j] * z[j];
            *(uint4*)(mix + r * DMIX + 2048 + c0) = pack8(y); }
    }
}

__device__ void phase5(const Params& p, unsigned char* lds) {
    const int tid = threadIdx.x, lane = tid & 63, w = __builtin_amdgcn_readfirstlane(tid >> 6);
    const float* hws = (const float*)(p.ws + WS_H);
    float* LG = (float*)lds; float* LB = LG + 2048;
    *(float4*)&LG[tid * 4] = *(const float4*)(p.ln_gain + tid * 4); *(float4*)&LB[tid * 4] = *(const float4*)(p.ln_bias + tid * 4);
    lds_barrier();
    auto fin = [&](float4 (&r)[8], const int row) __attribute__((always_inline)) {
        float s = 0.f;
#pragma unroll
        for (int i = 0; i < 8; ++i) s += (r[i].x + r[i].y) + (r[i].z + r[i].w);
#pragma unroll
        for (int o = 32; o > 0; o >>= 1) s += __shfl_xor(s, o);
        const float mu = s * (1.0f / 2048.0f); float q = 0.f;
#pragma unroll
        for (int i = 0; i < 8; ++i) { r[i].x -= mu; r[i].y -= mu; r[i].z -= mu; r[i].w -= mu; q += (r[i].x * r[i].x + r[i].y * r[i].y) + (r[i].z * r[i].z + r[i].w * r[i].w); }
#pragma unroll
        for (int o = 32; o > 0; o >>= 1) q += __shfl_xor(q, o);
        const float rs = rsqrtf(q * (1.0f / 2048.0f) + EPSV);
        float* yr = p.out + OFF_Y + (size_t)row * DM;
#pragma unroll
        for (int i = 0; i < 8; ++i) { const int col = i * 256 + lane * 4; const float4 g = *(const float4*)&LG[col], bb = *(const float4*)&LB[col];
            const pg8::f32x4 yv = {r[i].x * rs * g.x + bb.x, r[i].y * rs * g.y + bb.y, r[i].z * rs * g.z + bb.z, r[i].w * rs * g.w + bb.w}; __builtin_nontemporal_store(yv, (pg8::f32x4*)(yr + col)); }
    };
    if (w < 4) {
        for (int sr = blockIdx.x * 4 + w; sr < SROWS; sr += gridDim.x * 4) {
            const float* xr = p.x_sample + (size_t)sr * DM;
            const bf16_t* hp = (const bf16_t*)(p.ws + WS_HPART) + (size_t)sr * DM;
            float4 r[8];
#pragma unroll
            for (int i = 0; i < 8; ++i) { const pg8::f32x4 x4 = __builtin_nontemporal_load((const pg8::f32x4*)(xr + i * 256 + lane * 4)); r[i] = make_float4(ALPHA * x4.x, ALPHA * x4.y, ALPHA * x4.z, ALPHA * x4.w); }
#pragma unroll 2
            for (int kp = 0; kp < 8; ++kp) {
#pragma unroll
                for (int i = 0; i < 8; ++i) { const u32x2_t t = __builtin_nontemporal_load((const u32x2_t*)(hp + (size_t)kp * SROWS * DM + i * 256 + lane * 4)); r[i].x += bflo(t.x); r[i].y += bfhi(t.x); r[i].z += bflo(t.y); r[i].w += bfhi(t.y); } }
            fin(r, PROWS + sr);
        }
    }
    const int stride = gridDim.x * 8;
    int row = blockIdx.x * 8 + w;
    while (row < PROWS) {
        int nv = 1;
#pragma unroll
        for (int k = 1; k < 4; ++k) nv += (row + k * stride < PROWS) ? 1 : 0;
        float4 rr[4][8];
#pragma unroll
        for (int k = 0; k < 4; ++k) { const float* hk = hws + (size_t)(k < nv ? row + k * stride : row) * DM;
#pragma unroll
            for (int i = 0; i < 8; ++i) { const pg8::f32x4 t = __builtin_nontemporal_load((const pg8::f32x4*)(hk + i * 256 + lane * 4)); rr[k][i] = make_float4(t.x, t.y, t.z, t.w); } }
#pragma unroll
        for (int k = 0; k < 4; ++k) if (k < nv) fin(rr[k], row + k * stride);
        row += nv * stride;
    }
}


#define XB_TMO      128
#define XB_XCNT(j)  (256  + 64 * (j))
#define XB_XSUB(j)  (1280 + 64 * (j))
#define XB_XGEN(j)  (2304 + 64 * (j))
#define XB_TOP      3328
#define XB_TOPGEN   3392
#define XCD_BAR_WORDS 3456
#define XB_SPIN_CAP (1u << 18)
__device__ __forceinline__ unsigned xb_ld(unsigned* p)              { return __hip_atomic_load(p, __ATOMIC_RELAXED, __HIP_MEMORY_SCOPE_AGENT); }
__device__ __forceinline__ unsigned xb_add(unsigned* p, unsigned v) { return __hip_atomic_fetch_add(p, v, __ATOMIC_RELAXED, __HIP_MEMORY_SCOPE_AGENT); }
__device__ __forceinline__ unsigned xb_xcc_id() { return (unsigned)__builtin_amdgcn_s_getreg((3 << 11) | 20) & 0xFu; }
#define XB_SPIN(cond, bar) do { unsigned _sp = 0; while (cond) { __builtin_amdgcn_s_sleep(1); \
    if ((++_sp & 255u) == 0u) { if (xb_ld(&(bar)[XB_TMO])) break; if (_sp > XB_SPIN_CAP) { atomicAdd(&(bar)[XB_TMO], 1u); break; } } } } while (0)
struct XcdBarrier { unsigned* bar; unsigned x; volatile PG8_LAS unsigned* st; };
__device__ __forceinline__ XcdBarrier xcd_barrier_post(unsigned* bar, volatile PG8_LAS unsigned* st) {
    XcdBarrier b; b.bar = bar; b.x = xb_xcc_id(); b.st = st;
    if (threadIdx.x == 0) (void)xb_add(&bar[XB_XCNT(b.x)], 1u);
    return b;
}
__device__ __forceinline__ void xcd_barrier_complete(unsigned* bar, unsigned x, unsigned& nloc, unsigned& nx) {
    const unsigned G = gridDim.x * gridDim.y * gridDim.z;
    unsigned sum, cnt, mine, sp = 0u;
    for (;;) {
        sum = 0u; cnt = 0u; mine = 0u;
#pragma unroll
        for (unsigned j = 0; j < 16; ++j) { const unsigned c = xb_ld(&bar[XB_XCNT(j)]); sum += c; cnt += (c > 0u) ? 1u : 0u; mine = (j == x) ? c : mine; }
        if (sum == G) break;
        __builtin_amdgcn_s_sleep(1);
        if ((++sp & 255u) == 0u) { if (xb_ld(&bar[XB_TMO])) break; if (sp > XB_SPIN_CAP) { atomicAdd(&bar[XB_TMO], 1u); break; } }
    }
    nloc = mine > 0u ? mine : 1u; nx = cnt > 0u ? cnt : 1u;
}
__device__ __forceinline__ void xcd_barrier(const XcdBarrier& b) {
    asm volatile("s_waitcnt vmcnt(0)" ::: "memory");
    __syncthreads();
    if (threadIdx.x == 0) {
        unsigned* bar = b.bar;
        __builtin_amdgcn_s_waitcnt(0);
        unsigned nloc = b.st[0], nx = b.st[1];
        if (nloc == 0u) { xcd_barrier_complete(bar, b.x, nloc, nx); b.st[0] = nloc; b.st[1] = nx; }
        const unsigned old = xb_add(&bar[XB_XSUB(b.x)], 1u);
        const unsigned gen = old / nloc;
        if (old + 1u == (gen + 1u) * nloc) {
            __builtin_amdgcn_fence(__ATOMIC_RELEASE, "agent");
            asm volatile("s_waitcnt vmcnt(0)" ::: "memory");
            const unsigned og = xb_add(&bar[XB_TOP], 1u);
            const unsigned tg = og / nx;
            if (og + 1u == (tg + 1u) * nx) xb_add(&bar[XB_TOPGEN], 1u);
            else XB_SPIN(xb_ld(&bar[XB_TOPGEN]) == tg, bar);
            __builtin_amdgcn_fence(__ATOMIC_ACQUIRE, "agent");
            xb_add(&bar[XB_XGEN(b.x)], 1u);
            asm volatile("s_waitcnt vmcnt(0)" ::: "memory");
        } else {
            XB_SPIN(xb_ld(&bar[XB_XGEN(b.x)]) == gen, bar);
            __builtin_amdgcn_fence(__ATOMIC_ACQUIRE, "agent");
            asm volatile("s_waitcnt vmcnt(0)" ::: "memory");
        }
    }
    __syncthreads();
}

struct EpiRes {
    static constexpr bool PERM = false, AFTER_DRAIN = false;
    float* C; int ldc; const float* X;
    __device__ __forceinline__ void operator()(const pg8::f32x4 (&acc)[2][2][4][2], const pg8::Unit& u, int wr, int wc, int fr, int fq) const {
        using namespace pg8;
        const int row0 = u.pm * BM + wr * 64 + fr, col0 = u.pn * BM + wc * 32 + 4 * fq;
#pragma unroll
        for (int ai = 0; ai < 2; ++ai) {
            f32x4 xv[4][2][2];
#pragma unroll
            for (int m = 0; m < 4; ++m) { const float* xp = X + (size_t)(row0 + ai * HALF + m * 16) * ldc + col0;
#pragma unroll
                for (int bj = 0; bj < 2; ++bj)
#pragma unroll
                    for (int n = 0; n < 2; ++n) xv[m][bj][n] = __builtin_nontemporal_load((const f32x4*)(xp + bj * HALF + n * 16)); }
#pragma unroll
            for (int m = 0; m < 4; ++m) { float* rowp = C + (size_t)(row0 + ai * HALF + m * 16) * ldc + col0;
#pragma unroll
                for (int bj = 0; bj < 2; ++bj)
#pragma unroll
                    for (int n = 0; n < 2; ++n) *(f32x4*)(rowp + bj * HALF + n * 16) = acc[ai][bj][m][n] + ALPHA * xv[m][bj][n]; } }
    }
};
struct OneUnit { int pm, pn;
    __device__ bool next(int i, pg8::Unit& u) const { if (i) return false; u.pm = pm; u.pn = pn; return true; }
    __device__ __forceinline__ void a_ready(const pg8::Unit&) const {}
    __device__ __forceinline__ void done(const pg8::Unit&) const {} };
__global__ __launch_bounds__(512, 2) void mega(Params p) {
    extern __shared__ __attribute__((aligned(16))) unsigned char shm[];
    cg::grid_group grid = cg::this_grid();
    if (p.ph_lo < 0) grid.sync();
    const bool fused = p.ph_hi - p.ph_lo > 1;
    volatile PG8_LAS unsigned* st = (volatile PG8_LAS unsigned*)(PG8_LAS unsigned char*)(shm + LDS_STAGE);
    if (threadIdx.x == 0) { st[0] = 0u; st[1] = 0u; }
    __syncthreads();
    XcdBarrier xb; xb.bar = (unsigned*)(p.ws + WS_BAR); xb.x = 0; xb.st = st;
    if (fused) xb = xcd_barrier_post((unsigned*)(p.ws + WS_BAR), st);
#define SEAM() xcd_barrier(xb)
#ifndef PROBE_REP
#define PROBE_REP 0
#endif
#define RUN_PHASE(i, ...) if (p.ph_lo <= (i) && (i) < p.ph_hi) { if ((i) > p.ph_lo) SEAM(); __VA_ARGS__ if ((PROBE_REP >> (i)) & 1) { SEAM(); if ((i) == 2) { if (blockIdx.x == 0 && threadIdx.x == 0) *(unsigned*)(p.ws + WS_CTR) = 0u; SEAM(); } __VA_ARGS__ } }
    RUN_PHASE(0, phase0(p, shm);)
    RUN_PHASE(1, { pg8::Gemm g{(const bf16_t*)(p.ws + WS_A1), (const bf16_t*)(p.ws + WS_BT1), MROWS, NPROJ, DM, DM};
        pg8::StaticOrder S; S.init(MROWS, NPROJ, (int)gridDim.x, (int)blockIdx.x);
        EpiProj E{(bf16_t*)(p.ws + WS_PROJ), p.lb_logits};
        pg8::gemm_phase<EpiProj, pg8::StaticOrder, false>((PG8_LAS unsigned char*)shm, g, S, E, nullptr); })
    RUN_PHASE(2, phase2(p, shm);)
    RUN_PHASE(4, {
        { pg8::Gemm g{(const bf16_t*)(p.ws + WS_MIX), (const bf16_t*)(p.ws + WS_BT2), PROWS, DM, DMIX, DMIX};
          pg8::StaticOrder S; S.init(PROWS, DM, (int)gridDim.x, (int)blockIdx.x);
          EpiRes E{(float*)(p.ws + WS_H), DM, p.x_prompt};
          pg8::gemm_phase<EpiRes, pg8::StaticOrder, false>((PG8_LAS unsigned char*)shm, g, S, E, nullptr); }
        for (int q = blockIdx.x; q < 256; q += gridDim.x) { const int kp = q & 7, tile = q >> 3;
          __syncthreads();
          pg8::Gemm g{(const bf16_t*)(p.ws + WS_MIX) + (size_t)PROWS * DMIX + kp * 512, (const bf16_t*)(p.ws + WS_BT2) + kp * 512, SROWS, DM, 512, DMIX};
          OneUnit S{tile >> 3, tile & 7};
          pg8::EpiBf16<0> E{(bf16_t*)(p.ws + WS_HPART) + (size_t)kp * SROWS * DM, DM, nullptr, 0, 0};
          pg8::gemm_phase<pg8::EpiBf16<0>, OneUnit, false>((PG8_LAS unsigned char*)shm, g, S, E, nullptr); } })
    RUN_PHASE(5, phase5(p, shm);)
#ifdef PROBE_SYNC
    for (int i = 0; i < PROBE_SYNC; ++i) SEAM();
#endif
#undef RUN_PHASE
}

#ifndef N_LAUNCHES
#define N_LAUNCHES 1
#endif
extern "C" void kernel_launch(void* const* d_in, const int* in_sizes, int n_in, void* d_out, int out_size, void* d_ws, size_t ws_size, hipStream_t stream) {
    static int grid = 0;
    if (grid == 0) {
        if (n_in != 12 || ws_size < WS_END) { fprintf(stderr, "kernel_launch: unexpected shapes (n_in %d, ws %zu < %zu)\n", n_in, ws_size, (size_t)WS_END); grid = -1; return; }
        int dev = 0, cus = 0, per_cu = 0;
        hipGetDevice(&dev); hipDeviceGetAttribute(&cus, hipDeviceAttributeMultiprocessorCount, dev);
        if (hipFuncSetAttribute((const void*)mega, hipFuncAttributeMaxDynamicSharedMemorySize, LDS_BYTES) != hipSuccess) { fprintf(stderr, "kernel_launch: hipFuncSetAttribute failed\n"); grid = -1; return; }
        if (hipOccupancyMaxActiveBlocksPerMultiprocessor(&per_cu, (const void*)mega, 512, LDS_BYTES) != hipSuccess || per_cu < 1) { fprintf(stderr, "kernel_launch: occupancy query says %d\n", per_cu); per_cu = 1; }
        (void)hipGetLastError();
        grid = cus * 1;
        if (grid <= 0) grid = 256;
    }
    if (grid < 0) return;
    Params p{};
    p.x_prompt = (const float*)d_in[0]; p.x_sample = (const float*)d_in[1]; p.state_conv = (const float*)d_in[2]; p.state_hgrn = (const float*)d_in[3];
    p.w_in = (const float*)d_in[4]; p.conv_w = (const float*)d_in[5]; p.norm_a = (const float*)d_in[6]; p.lb_logits = (const float*)d_in[7]; p.norm_b = (const float*)d_in[8];
    p.w_out = (const float*)d_in[9]; p.ln_gain = (const float*)d_in[10]; p.ln_bias = (const float*)d_in[11];
    p.out = (float*)d_out; p.ws = (unsigned char*)d_ws;
    (void)hipMemsetAsync((unsigned char*)d_ws + WS_CTR, 0, WS_END - WS_CTR, stream);
#if N_LAUNCHES == 1
    p.ph_lo = 0; p.ph_hi = 6;
    void* args[] = {&p};
    hipError_t e = hipLaunchCooperativeKernel((const void*)mega, dim3(grid), dim3(512), args, LDS_BYTES, stream);
    if (e != hipSuccess) fprintf(stderr, "cooperative launch failed: %s (grid %d)\n", hipGetErrorString(e), grid);
#else
    for (int i = 0; i < 6; ++i) { p.ph_lo = i; p.ph_hi = i + 1; hipLaunchKernelGGL(mega, dim3(grid), dim3(512), LDS_BYTES, stream, p); }
#endif
}
```

```cpp
#include <hip/hip_runtime.h>
namespace pg8 {
#define PG8_LAS __attribute__((address_space(3)))
typedef unsigned short bf16_t;
typedef short bf16x8 __attribute__((ext_vector_type(8)));
typedef float f32x4 __attribute__((ext_vector_type(4)));
typedef unsigned u32x4 __attribute__((ext_vector_type(4)));
constexpr int BM = 256, BK = 64, HALF = 128, HTB = HALF * BK * 2  , STAGE_BYTES = 8 * HTB, NXCD = 8, WGM = 8;

__host__ __device__ __forceinline__ int lds_byte(int r, int c) { const int st = (r >> 4) * 2 + (c >> 5), rr = r & 15, cc = c & 31, ob = rr * 64 + cc * 2; return st * 1024 + (ob ^ (((ob >> 9) & 1) << 5)); }
__host__ __device__ __forceinline__ void stage_rc(int b, int& R, int& C) { const int st = b / 1024, sb = b % 1024, swz = sb ^ (((sb >> 9) & 1) << 5); R = (st >> 1) * 16 + swz / 64; C = (st & 1) * 32 + (swz % 64) / 2; }
__host__ __device__ __forceinline__ int perm32(int rho) { const int n = rho >> 4, i = rho & 15; return 8 * (i >> 2) + 4 * n + (i & 3); }

struct Unit { int pm, pn; };
struct Gemm { const bf16_t* A; const bf16_t* Bt; int M, N, K, ld; };

struct StaticOrder {
    int nM, nN, nwg, G, c;
    __host__ __device__ void init(int M, int N, int G_, int c_) { nM = M / BM; nN = N / BM; nwg = nM * nN; G = G_; c = c_; }
    __host__ __device__ bool next(int i, Unit& u) const {
        const long L = (long)i * G + c; if (L >= nwg) return false;
        int wgid = (int)L; { const int q = nwg / NXCD, r = nwg % NXCD, xcd = wgid % NXCD, off = wgid / NXCD; wgid = (xcd < r ? xcd * (q + 1) : r * (q + 1) + (xcd - r) * q) + off; }
        const int nig = WGM * nN, gid = wgid / nig, fm = gid * WGM, gsz = (nM - fm) < WGM ? (nM - fm) : WGM;
        u.pm = fm + ((wgid % nig) % gsz); u.pn = (wgid % nig) / gsz; return true;
    }
    __device__ __forceinline__ void a_ready(const Unit&) const {}
    __device__ __forceinline__ void done(const Unit&) const {}
};
__device__ __forceinline__ unsigned cvt_pk_bf16(float lo, float hi) { unsigned r; asm volatile("v_cvt_pk_bf16_f32 %0, %1, %2" : "=v"(r) : "v"(lo), "v"(hi)); return r; }
typedef float f32x2 __attribute__((ext_vector_type(2)));
__device__ __forceinline__ f32x2 gelu_pk(f32x2 v) {
    const f32x2 av = __builtin_elementwise_abs(v), d = av * 0.2316418882f + 1.0f;
    f32x2 t; t.x = __builtin_amdgcn_rcpf(d.x); t.y = __builtin_amdgcn_rcpf(d.y);
    f32x2 q = t * 0.5307027145f + (-0.7265760135f); q = q * t + 0.7107068705f; q = q * t + (-0.142248368f); q = q * t + 0.127414796f; q = q * t;
    const f32x2 s = (v * v) * (-0.72134752044f);
    f32x2 e; e.x = __builtin_amdgcn_exp2f(s.x); e.y = __builtin_amdgcn_exp2f(s.y);
    const f32x2 m = v * (q * e), r = v - m;
    f32x2 o; o.x = v.x < 0.f ? m.x : r.x; o.y = v.y < 0.f ? m.y : r.y; return o;
}

struct EpiF32 {
    static constexpr bool PERM = false, AFTER_DRAIN = false;
    float* C; int ldc; const float* bias;
    __device__ __forceinline__ void operator()(const f32x4 (&acc)[2][2][4][2], const Unit& u, int wr, int wc, int fr, int fq) const {
        const int row0 = u.pm * BM + wr * 64 + fr, col0 = u.pn * BM + wc * 32 + 4 * fq;
        f32x4 bv[2][2];
#pragma unroll
        for (int bj = 0; bj < 2; ++bj)
#pragma unroll
            for (int n = 0; n < 2; ++n) bv[bj][n] = bias ? *(const f32x4*)(bias + col0 + bj * HALF + n * 16) : (f32x4){0.f, 0.f, 0.f, 0.f};
#pragma unroll
        for (int ai = 0; ai < 2; ++ai)
#pragma unroll
            for (int m = 0; m < 4; ++m) { float* rowp = C + (size_t)(row0 + ai * HALF + m * 16) * ldc + col0;
#pragma unroll
                for (int bj = 0; bj < 2; ++bj)
#pragma unroll
                    for (int n = 0; n < 2; ++n) *(f32x4*)(rowp + bj * HALF + n * 16) = acc[ai][bj][m][n] + bv[bj][n]; }
    }
};
template <int ACT  > struct EpiBf16 {
    static constexpr bool PERM = true, AFTER_DRAIN = false;
    bf16_t* O; int ldc; const float* bias; int split_cols; size_t split_stride;
    __device__ __forceinline__ void operator()(const f32x4 (&acc)[2][2][4][2], const Unit& u, int wr, int wc, int fr, int fq) const {
        const int row0 = u.pm * BM + wr * 64 + fr; int colt = u.pn * BM; bf16_t* base = O;
        if (split_cols) { const int t = colt / split_cols; base += (size_t)t * split_stride; colt -= t * split_cols; }
        const int col0 = colt + wc * 32 + 8 * fq, bcol0 = u.pn * BM + wc * 32 + 8 * fq;
        f32x4 bv[2][2];
#pragma unroll
        for (int bj = 0; bj < 2; ++bj)
#pragma unroll
            for (int n = 0; n < 2; ++n) bv[bj][n] = bias ? *(const f32x4*)(bias + bcol0 + bj * HALF + 4 * n) : (f32x4){0.f, 0.f, 0.f, 0.f};
#pragma unroll
        for (int ai = 0; ai < 2; ++ai)
#pragma unroll
            for (int m = 0; m < 4; ++m) { bf16_t* rowp = base + (size_t)(row0 + ai * HALF + m * 16) * ldc + col0;
#pragma unroll
                for (int bj = 0; bj < 2; ++bj) { f32x4 v0 = acc[ai][bj][m][0] + bv[bj][0], v1 = acc[ai][bj][m][1] + bv[bj][1];
                    if (ACT == 1) { f32x2 a = gelu_pk((f32x2){v0[0], v0[1]}), b = gelu_pk((f32x2){v0[2], v0[3]}), c = gelu_pk((f32x2){v1[0], v1[1]}), d = gelu_pk((f32x2){v1[2], v1[3]});
                        v0 = (f32x4){a.x, a.y, b.x, b.y}; v1 = (f32x4){c.x, c.y, d.x, d.y}; }
                    if (ACT == 2) {
#pragma unroll
                        for (int j = 0; j < 4; ++j) { v0[j] = 0.5f * v0[j] * (1.0f + erff(v0[j] * 0.70710678f)); v1[j] = 0.5f * v1[j] * (1.0f + erff(v1[j] * 0.70710678f)); } }
                    u32x4 w; w.x = cvt_pk_bf16(v0[0], v0[1]); w.y = cvt_pk_bf16(v0[2], v0[3]); w.z = cvt_pk_bf16(v1[0], v1[1]); w.w = cvt_pk_bf16(v1[2], v1[3]);
                    *(u32x4*)(rowp + bj * HALF) = w; } }
    }
};

template <class Epi, class Sched, bool STAMP = false>
__device__ __forceinline__ void gemm_phase(PG8_LAS unsigned char* lds, const Gemm g, const Sched& S, const Epi& E, unsigned long long* stamps) {
    const int tid = threadIdx.x, wid = __builtin_amdgcn_readfirstlane(tid >> 6), lane = tid & 63, wr = wid >> 2, wc = wid & 3, fr = lane & 15, fq = lane >> 4;
    const int K = g.ld, nt = g.K / BK;
    int ts_lo = 0, ts_hi = 0, nts = 0; const unsigned long long rt_entry = STAMP ? (unsigned long long)wall_clock64() : 0ull;
#define PG8_STAMP() do { if (STAMP && wid == 0 && nts < 64) { const unsigned long long _c = (unsigned long long)clock64(); \
        ts_lo = (lane == nts) ? (int)(unsigned)_c : ts_lo; ts_hi = (lane == nts) ? (int)(unsigned)(_c >> 32) : ts_hi; ++nts; } } while (0)
    PG8_STAMP();
    unsigned voffA[2], voffB[2];
#pragma unroll
    for (int i = 0; i < 2; ++i) { int R, C; stage_rc(tid * 16 + i * 8192, R, C); const int Rb = Epi::PERM ? ((R & ~31) + perm32(R & 31)) : R;
        voffA[i] = (unsigned)(R * K + C) * 2u; voffB[i] = (unsigned)(Rb * K + C) * 2u; }
    const size_t kstep = (size_t)(BK * 2);
    const size_t hstep = (size_t)HALF * K * 2;
    const size_t tstep = 2 * hstep;
    const unsigned ldsw = (unsigned)wid * 1024u;
    const int aoff = lds_byte(wr * 64 + fr, fq * 8), boff = lds_byte(wc * 32 + fr, fq * 8);
#define PG8_SA(b, h) (((b) * 2 + (h)) * HTB)
#define PG8_SB(b, h) ((4 + (b) * 2 + (h)) * HTB)
#define PG8_STAGE(bufoff, gbase, voff) do { _Pragma("unroll") for (int _i = 0; _i < 2; ++_i) \
        __builtin_amdgcn_global_load_lds((const unsigned*)((const char*)(gbase) + (voff)[_i]), (PG8_LAS unsigned*)(lds + (bufoff) + ldsw + _i * 8192), 16, 0, 0); } while (0)
#define PG8_LDA(dst, b, h) do { _Pragma("unroll") for (int m = 0; m < 4; ++m) _Pragma("unroll") for (int k = 0; k < 2; ++k) dst[m][k] = *(const PG8_LAS bf16x8*)(lds + PG8_SA(b, h) + aoff + m * 2048 + k * 1024); } while (0)
#define PG8_LDB(dst, b, h) do { _Pragma("unroll") for (int n = 0; n < 2; ++n) _Pragma("unroll") for (int k = 0; k < 2; ++k) dst[n][k] = *(const PG8_LAS bf16x8*)(lds + PG8_SB(b, h) + boff + n * 2048 + k * 1024); } while (0)
#define PG8_MMA(ai, bj, At, Bt) do { __builtin_amdgcn_s_setprio(1); _Pragma("unroll") for (int m = 0; m < 4; ++m) _Pragma("unroll") for (int n = 0; n < 2; ++n) _Pragma("unroll") for (int k = 0; k < 2; ++k) \
        acc[ai][bj][m][n] = __builtin_amdgcn_mfma_f32_16x16x32_bf16(Bt[n][k], At[m][k], acc[ai][bj][m][n], 0, 0, 0); __builtin_amdgcn_s_setprio(0); } while (0)
#define PG8_WAIT_V(n) asm volatile("s_waitcnt vmcnt(" #n ")" ::: "memory")
#define PG8_WAIT_L(n) asm volatile("s_waitcnt lgkmcnt(" #n ")" ::: "memory")
#define PG8_BAR __builtin_amdgcn_s_barrier()
#define PG8_SCHED __builtin_amdgcn_sched_barrier(0)
    Unit cur, nxt; int ui = 0;
    if (!S.next(0, cur)) return;
    f32x4 acc[2][2][4][2];
#pragma unroll
    for (int a = 0; a < 2; ++a)
#pragma unroll
        for (int b = 0; b < 2; ++b)
#pragma unroll
            for (int m = 0; m < 4; ++m)
#pragma unroll
                for (int n = 0; n < 2; ++n) acc[a][b][m][n] = (f32x4){0.f, 0.f, 0.f, 0.f};
    bf16x8 At[4][2], B0[2][2], B1[2][2];
    const char* cA = (const char*)g.A + (size_t)cur.pm * tstep; const char* cB = (const char*)g.Bt + (size_t)cur.pn * tstep;
    S.a_ready(cur);
    PG8_STAGE(PG8_SB(0, 0), cB, voffB); PG8_STAGE(PG8_SA(0, 0), cA, voffA); PG8_STAGE(PG8_SB(0, 1), cB + hstep, voffB); PG8_STAGE(PG8_SA(0, 1), cA + hstep, voffA);
    if (wr == 1) PG8_BAR;
    PG8_WAIT_V(4); PG8_BAR;
    PG8_STAGE(PG8_SB(1, 0), cB + kstep, voffB); PG8_STAGE(PG8_SA(1, 0), cA + kstep, voffA); PG8_STAGE(PG8_SB(1, 1), cB + hstep + kstep, voffB);
    PG8_WAIT_V(6); PG8_BAR;
    PG8_STAMP();
    for (;;) {
        const bool has_next = S.next(ui + 1, nxt);
        const char* nA = has_next ? (const char*)g.A + (size_t)nxt.pm * tstep : cA; const char* nB = has_next ? (const char*)g.Bt + (size_t)nxt.pn * tstep : cB;
        for (int t = 0; t < nt; t += 2) {
            const bool last = (t == nt - 2);
            const char* a1 = cA + (size_t)(t + 1) * kstep;
            const char* a2 = last ? nA : cA + (size_t)(t + 2) * kstep; const char* b2 = last ? nB : cB + (size_t)(t + 2) * kstep;
            const char* a3 = a2 + kstep; const char* b3 = b2 + kstep;
            if (last && has_next) S.a_ready(nxt);
            PG8_LDB(B0, 0, 0); PG8_SCHED; PG8_LDA(At, 0, 0); PG8_STAGE(PG8_SA(1, 1), a1 + hstep, voffA);
            PG8_WAIT_L(8); PG8_BAR; PG8_WAIT_L(0); PG8_MMA(0, 0, At, B0); PG8_BAR; PG8_SCHED;
            PG8_LDB(B1, 0, 1); PG8_STAGE(PG8_SB(0, 0), b2, voffB);
            PG8_BAR; PG8_WAIT_L(0); PG8_MMA(0, 1, At, B1); PG8_BAR;
            PG8_LDA(At, 0, 1); PG8_STAGE(PG8_SA(0, 0), a2, voffA);
            PG8_BAR; PG8_WAIT_L(0); PG8_MMA(1, 0, At, B0); PG8_BAR; PG8_SCHED;
            PG8_STAGE(PG8_SB(0, 1), b2 + hstep, voffB);
            PG8_WAIT_V(6); PG8_BAR; PG8_MMA(1, 1, At, B1); PG8_BAR;
            PG8_LDB(B0, 1, 0); PG8_SCHED; PG8_LDA(At, 1, 0); PG8_STAGE(PG8_SA(0, 1), a2 + hstep, voffA);
            PG8_WAIT_L(8); PG8_BAR; PG8_WAIT_L(0); PG8_MMA(0, 0, At, B0); PG8_BAR; PG8_SCHED;
            PG8_LDB(B1, 1, 1); PG8_STAGE(PG8_SB(1, 0), b3, voffB);
            PG8_BAR; PG8_WAIT_L(0); PG8_MMA(0, 1, At, B1); PG8_BAR;
            PG8_LDA(At, 1, 1); PG8_STAGE(PG8_SA(1, 0), a3, voffA);
            PG8_BAR; PG8_WAIT_L(0); PG8_MMA(1, 0, At, B0); PG8_BAR; PG8_SCHED;
            PG8_STAGE(PG8_SB(1, 1), b3 + hstep, voffB);
            PG8_WAIT_V(6); PG8_BAR; PG8_MMA(1, 1, At, B1); PG8_BAR;
        }
        PG8_STAMP();
        if constexpr (!Epi::AFTER_DRAIN) { E(acc, cur, wr, wc, fr, fq); S.done(cur); }
        PG8_STAMP();
        if (!has_next) break;
#pragma unroll
        for (int a = 0; a < 2; ++a)
#pragma unroll
            for (int b = 0; b < 2; ++b)
#pragma unroll
                for (int m = 0; m < 4; ++m)
#pragma unroll
                    for (int n = 0; n < 2; ++n) acc[a][b][m][n] = (f32x4){0.f, 0.f, 0.f, 0.f};
        cur = nxt; cA = nA; cB = nB; ++ui;
    }
    PG8_WAIT_V(0);
    if (wr == 0) PG8_BAR;
    PG8_BAR;
    if constexpr (Epi::AFTER_DRAIN) { E.fused(acc, cur, wr, wc, fr, fq, lds, wid, lane); S.done(cur); }
    PG8_STAMP();
    if (STAMP && wid == 0) { stamps[lane] = lane < nts ? (((unsigned long long)(unsigned)ts_hi << 32) | (unsigned)ts_lo) : 0ull;
        if (lane == 62) stamps[62] = rt_entry; if (lane == 63) stamps[63] = (unsigned long long)wall_clock64(); }
#undef PG8_STAMP
#undef PG8_SA
#undef PG8_SB
#undef PG8_STAGE
#undef PG8_LDA
#undef PG8_LDB
#undef PG8_MMA
#undef PG8_WAIT_V
#undef PG8_WAIT_L
#undef PG8_BAR
#undef PG8_SCHED
}
}

#include <cstdio>
#include <ctime>
#include <cstdlib>
#include <cstring>
#include <cmath>
#include <vector>
#include <algorithm>
#define CK(x) do { hipError_t e_ = (x); if (e_ != hipSuccess) { fprintf(stderr, "HIP %s:%d %s\n", __FILE__, __LINE__, hipGetErrorString(e_)); exit(2); } } while (0)
#include <hip/hip_cooperative_groups.h>
#include <cstdio>
namespace cg = cooperative_groups;
using pg8::bf16_t;
typedef float f32x2_t __attribute__((ext_vector_type(2)));
typedef unsigned u32x2_t __attribute__((ext_vector_type(2)));
typedef __bf16 bf16x2_t __attribute__((ext_vector_type(2)));
__device__ __forceinline__ unsigned pkbf(float lo, float hi) { const f32x2_t v = {lo, hi}; const bf16x2_t r = __builtin_convertvector(v, bf16x2_t); return __builtin_bit_cast(unsigned, r); }

constexpr int DM = 2048, NPROJ = 16384, DMIX = 4096;
constexpr int PROWS = 8192, SROWS = 1024, MROWS = 9216;
constexpr int LDS_STAGE = 131072, LDS_BYTES = LDS_STAGE + 64;
constexpr float EPSV = 1e-5f;
constexpr float ALPHA = 1.189207115002721f;
constexpr float QSCALE = 0.08838834764831845f;

constexpr size_t WS_A1 = 0;
constexpr size_t WS_BT1 = WS_A1 + (size_t)MROWS * DM * 2;
constexpr size_t WS_O = 0;
constexpr size_t WS_BT2 = WS_BT1 + (size_t)NPROJ * DM * 2;
constexpr size_t WS_PROJ = WS_BT2 + (size_t)DM * DMIX * 2;
constexpr size_t WS_H = WS_PROJ;
constexpr size_t WS_HPART = WS_H + (size_t)MROWS * DM * 4;
constexpr size_t WS_MIX = WS_PROJ + (size_t)MROWS * NPROJ * 2;
constexpr size_t WS_CTR = WS_MIX + (size_t)MROWS * DMIX * 2;
constexpr size_t WS_BAR = WS_CTR + 256;
constexpr size_t WS_END = WS_BAR + 3456 * 4;

constexpr size_t OFF_Y = 0;
constexpr size_t OFF_NCP = (size_t)MROWS * DM;
constexpr size_t OFF_NHP = OFF_NCP + 4 * 2 * 2048;
constexpr size_t OFF_NCS = OFF_NHP + (size_t)4 * 16 * 128 * 128;
constexpr size_t OFF_NHS = OFF_NCS + (size_t)128 * 2 * 2048;

struct Params {
    const float* x_prompt; const float* x_sample; const float* state_conv; const float* state_hgrn;
    const float* w_in; const float* conv_w; const float* norm_a; const float* lb_logits; const float* norm_b;
    const float* w_out; const float* ln_gain; const float* ln_bias;
    float* out; unsigned char* ws;
    int ph_lo, ph_hi;
};

__device__ __forceinline__ float bflo(unsigned u) { return __uint_as_float(u << 16); }
__device__ __forceinline__ float bfhi(unsigned u) { return __uint_as_float(u & 0xffff0000u); }
__device__ __forceinline__ void unpack8(const uint4 r, float (&f)[8]) {
    f[0] = bflo(r.x); f[1] = bfhi(r.x); f[2] = bflo(r.y); f[3] = bfhi(r.y); f[4] = bflo(r.z); f[5] = bfhi(r.z); f[6] = bflo(r.w); f[7] = bfhi(r.w);
}
__device__ __forceinline__ uint4 pack8(const float (&f)[8]) {
    uint4 r; r.x = pkbf(f[0], f[1]); r.y = pkbf(f[2], f[3]); r.z = pkbf(f[4], f[5]); r.w = pkbf(f[6], f[7]); return r;
}
__device__ __forceinline__ uint4 ntl16(const void* p) { const pg8::u32x4 t = __builtin_nontemporal_load((const pg8::u32x4*)p); return make_uint4(t.x, t.y, t.z, t.w); }
__device__ __forceinline__ float sigm(float x) { return 1.0f / (1.0f + __expf(-x)); }
__device__ __forceinline__ float silu(float x) { return x / (1.0f + __expf(-x)); }
__device__ __forceinline__ void lds_barrier() { asm volatile("s_waitcnt lgkmcnt(0)" ::: "memory"); __builtin_amdgcn_s_barrier(); asm volatile("" ::: "memory"); }
#define DPP_ROR(x, n) __builtin_bit_cast(float, __builtin_amdgcn_update_dpp(0, __builtin_bit_cast(int, (x)), 0x120 + (n), 0xF, 0xF, true))
__device__ __forceinline__ float row16_sum(float x) { x += DPP_ROR(x, 8); x += DPP_ROR(x, 4); x += DPP_ROR(x, 2); x += DPP_ROR(x, 1); return x; }


typedef _Float16 h16x2 __attribute__((ext_vector_type(2)));
__device__ __forceinline__ unsigned pack_h2(float a, float b) { const h16x2 v = {(_Float16)a, (_Float16)b}; return __builtin_bit_cast(unsigned, v); }
__device__ __forceinline__ float h2lo(unsigned u) { return (float)__builtin_bit_cast(h16x2, u)[0]; }
__device__ __forceinline__ float h2hi(unsigned u) { return (float)__builtin_bit_cast(h16x2, u)[1]; }
__device__ __forceinline__ float ex2(float x) { return __builtin_amdgcn_exp2f(x); }

struct EpiProj {
    static constexpr bool PERM = true, AFTER_DRAIN = false;
    bf16_t* O; const float* lbl;
    __device__ __forceinline__ void operator()(const pg8::f32x4 (&acc)[2][2][4][2], const pg8::Unit& u, int wr, int wc, int fr, int fq) const {
        using namespace pg8;
        const int row0 = u.pm * BM + wr * 64 + fr, seg = u.pn >> 3, col0 = u.pn * BM + wc * 32 + 8 * fq;
        if (seg == 5) {
            float lb[2][8];
#pragma unroll
            for (int bj = 0; bj < 2; ++bj) { const float* l0 = lbl + (col0 - 5 * 2048) + bj * HALF; const float* l1 = l0 + 2048;
                const f32x4 a0 = *(const f32x4*)l0, a1 = *(const f32x4*)(l0 + 4), b0 = *(const f32x4*)l1, b1 = *(const f32x4*)(l1 + 4);
#pragma unroll
                for (int j = 0; j < 4; ++j) { lb[bj][j] = 1.0f / (1.0f + __expf(b0[j] - a0[j])); lb[bj][4 + j] = 1.0f / (1.0f + __expf(b1[j] - a1[j])); } }
#pragma unroll
            for (int ai = 0; ai < 2; ++ai)
#pragma unroll
                for (int m = 0; m < 4; ++m) { const size_t row = (size_t)(row0 + ai * HALF + m * 16);
#pragma unroll
                    for (int bj = 0; bj < 2; ++bj) { const f32x4 v0 = acc[ai][bj][m][0], v1 = acc[ai][bj][m][1];
                        float g[8];
#pragma unroll
                        for (int j = 0; j < 4; ++j) { g[j] = lb[bj][j] + (1.0f - lb[bj][j]) * sigm(v0[j]); g[4 + j] = lb[bj][4 + j] + (1.0f - lb[bj][4 + j]) * sigm(v1[j]); }
                        u32x4 wg; wg.x = pack_h2(g[0], g[1]); wg.y = pack_h2(g[2], g[3]); wg.z = pack_h2(g[4], g[5]); wg.w = pack_h2(g[6], g[7]);
                        *(u32x4*)(O + row * NPROJ + col0 + bj * HALF) = wg; } }
        } else {
            const bool act = (seg == 3) | (seg == 4) | (seg == 7); const float sc = seg == 4 ? QSCALE : 1.0f;
#pragma unroll
            for (int ai = 0; ai < 2; ++ai)
#pragma unroll
                for (int m = 0; m < 4; ++m) { bf16_t* rowp = O + (size_t)(row0 + ai * HALF + m * 16) * NPROJ + col0;
#pragma unroll
                    for (int bj = 0; bj < 2; ++bj) { f32x4 v0 = acc[ai][bj][m][0], v1 = acc[ai][bj][m][1];
                        if (act) {
#pragma unroll
                            for (int j = 0; j < 4; ++j) { v0[j] = silu(v0[j]) * sc; v1[j] = silu(v1[j]) * sc; } }
                        u32x4 w; w.x = pkbf(v0[0], v0[1]); w.y = pkbf(v0[2], v0[3]); w.z = pkbf(v1[0], v1[1]); w.w = pkbf(v1[2], v1[3]);
                        *(u32x4*)(rowp + bj * HALF) = w; } }
        }
    }
};

__device__ __forceinline__ void p0_tile_info(const Params& p, int tile, const float*& src, int& ld, bf16_t*& dst, int& ldd) {
    if (tile < 2048) { const int kt = tile >> 6, nt = tile & 63; src = p.w_in + (size_t)(kt * 64) * NPROJ + nt * 256; ld = NPROJ;
        dst = (bf16_t*)(p.ws + WS_BT1) + (size_t)(nt * 256) * DM + kt * 64; ldd = DM; }
    else { const int t2 = tile - 2048, kt = t2 >> 3, nt = t2 & 7; src = p.w_out + (size_t)(kt * 64) * DM + nt * 256; ld = DM;
        dst = (bf16_t*)(p.ws + WS_BT2) + (size_t)(nt * 256) * DMIX + kt * 64; ldd = DMIX; }
}
__device__ void phase0(const Params& p, unsigned char* lds) {
    float* T = (float*)lds;
    const int tid = threadIdx.x;
    if (blockIdx.x == 0 && tid == 0) *(unsigned*)(p.ws + WS_CTR) = 0u;
    constexpr int NT = 2048 + 512;
    pg8::f32x4 r[8];
    int tile = blockIdx.x;
    const float* src = nullptr; int ld = 0; bf16_t* dst = nullptr; int ldd = 0;
    p0_tile_info(p, tile < NT ? tile : NT - 1, src, ld, dst, ldd);
#pragma unroll
    for (int i = 0; i < 8; ++i) r[i] = __builtin_nontemporal_load((const pg8::f32x4*)(src + (size_t)(i * 8 + (tid >> 6)) * ld + (tid & 63) * 4));
    while (tile < NT) {
#pragma unroll
        for (int i = 0; i < 8; ++i) { const int k = i * 8 + (tid >> 6), n = (tid & 63) * 4; *(pg8::f32x4*)&T[k * 256 + (n ^ (i << 3))] = r[i]; }
        bf16_t* cdst = dst; const int cldd = ldd;
        const int nxt = tile + gridDim.x;
        p0_tile_info(p, nxt < NT ? nxt : NT - 1, src, ld, dst, ldd);
#pragma unroll
        for (int i = 0; i < 8; ++i) r[i] = __builtin_nontemporal_load((const pg8::f32x4*)(src + (size_t)(i * 8 + (tid >> 6)) * ld + (tid & 63) * 4));
        lds_barrier();
#pragma unroll
        for (int c = 0; c < 4; ++c) { const int q = tid + 512 * c, n = q >> 3, k8 = q & 7; float v[8];
#pragma unroll
            for (int j = 0; j < 8; ++j) v[j] = T[(k8 * 8 + j) * 256 + (n ^ (k8 << 3))];
            *(uint4*)(cdst + (size_t)n * cldd + k8 * 8) = pack8(v); }
        lds_barrier();
        tile = nxt;
    }
    bf16_t* A1 = (bf16_t*)(p.ws + WS_A1);
    constexpr size_t total8 = (size_t)MROWS * DM / 8, pe = (size_t)PROWS * DM;
    const size_t stride = (size_t)gridDim.x * 512;
    for (size_t i = (size_t)blockIdx.x * 512 + tid; i < total8; i += 3 * stride) {
        const size_t i0 = i, i1 = i + stride, i2 = i + 2 * stride;
        const size_t j1 = i1 < total8 ? i1 : i0, j2 = i2 < total8 ? i2 : i0;
        const size_t e0 = i0 * 8, e1 = j1 * 8, e2 = j2 * 8;
        const float* s0 = e0 < pe ? p.x_prompt + e0 : p.x_sample + (e0 - pe);
        const float* s1 = e1 < pe ? p.x_prompt + e1 : p.x_sample + (e1 - pe);
        const float* s2 = e2 < pe ? p.x_prompt + e2 : p.x_sample + (e2 - pe);
        const pg8::f32x4 a0 = __builtin_nontemporal_load((const pg8::f32x4*)s0), b0 = __builtin_nontemporal_load((const pg8::f32x4*)(s0 + 4)), a1 = __builtin_nontemporal_load((const pg8::f32x4*)s1), b1 = __builtin_nontemporal_load((const pg8::f32x4*)(s1 + 4)), a2 = __builtin_nontemporal_load((const pg8::f32x4*)s2), b2 = __builtin_nontemporal_load((const pg8::f32x4*)(s2 + 4));
        { const float v[8] = {a0.x, a0.y, a0.z, a0.w, b0.x, b0.y, b0.z, b0.w}; *(uint4*)(A1 + e0) = pack8(v); }
        if (i1 < total8) { const float v[8] = {a1.x, a1.y, a1.z, a1.w, b1.x, b1.y, b1.z, b1.w}; *(uint4*)(A1 + e1) = pack8(v); }
        if (i2 < total8) { const float v[8] = {a2.x, a2.y, a2.z, a2.w, b2.x, b2.y, b2.z, b2.w}; *(uint4*)(A1 + e2) = pack8(v); }
    }
}

__device__ __forceinline__ pg8::bf16x8 ldfrag(const unsigned char* p) { const uint4 r = *(const uint4*)p; return __builtin_bit_cast(pg8::bf16x8, r); }
__device__ void hgrn_prompt_item(const Params& p, unsigned char* lds, int it) {
    using pg8::bf16x8; using pg8::f32x4;
    const int h = it & 15, b = it >> 4;
    unsigned char* QE = lds; unsigned char* KE = lds + 18432; unsigned char* KTT = lds + 36864; unsigned char* VT = lds + 57344;
    float* TOT = (float*)(lds + 77824); float* DL = (float*)(lds + 81920); float* OB = (float*)(lds + 82432);
    int tid = threadIdx.x; asm volatile("" : "+v"(tid));
    const int lane = tid & 63, w = tid >> 6, fr = lane & 15, kq = lane >> 4;
    const size_t row0 = (size_t)b * 2048;
    bf16_t* mix = (bf16_t*)(p.ws + WS_MIX);
    const char* pbase = (const char*)(p.ws + WS_PROJ) + (row0 * NPROJ + 4 * 2048 + h * 128) * 2;
    const int m16 = lane & 15;
    const int qoff = (32 * (lane >> 4) + 8 * ((m16 & 7) >> 1) + 4 * (m16 >> 3) + 2 * (m16 & 1)) * 2;
    const int sc0 = ((4 * (w >> 2) + 2 * (w & 1)) ^ (lane & 7)) * 16 + 8 * ((w >> 1) & 1), sc1 = ((4 * (w >> 2) + 2 * (w & 1) + 1) ^ (lane & 7)) * 16 + 8 * ((w >> 1) & 1);
    const unsigned voff = (unsigned)((8 * w * NPROJ + 2 * lane) * 2);
    unsigned rq[8], rf[8], rv[8];
#define HG_PF(c) do { const char* cb = pbase + (size_t)(c) * 64 * NPROJ * 2; _Pragma("unroll") for (int i = 0; i < 8; ++i) { const char* ri = cb + (size_t)i * NPROJ * 2; \
        rq[i] = *(const unsigned*)(ri + voff); rf[i] = *(const unsigned*)(ri + 4096 + voff); rv[i] = *(const unsigned*)(ri + 8192 + voff); } } while (0)
    HG_PF(0);
    f32x4 S[8];
#pragma unroll
    for (int i = 0; i < 8; ++i) S[i] = (f32x4){0.f, 0.f, 0.f, 0.f};
    for (int c = 0; c < 32; ++c) {
        float e0[8], e1[8]; float a0 = 1.f, a1 = 1.f;
#pragma unroll
        for (int i = 0; i < 8; ++i) { a0 *= h2lo(rf[i]); a1 *= h2hi(rf[i]); e0[i] = a0; e1[i] = a1; }
        *(float2*)&TOT[w * 128 + 2 * lane] = make_float2(a0, a1);
        lds_barrier();
        float off0 = 1.f, off1 = 1.f, tot0 = 1.f, tot1 = 1.f;
#pragma unroll
        for (int ww = 0; ww < 8; ++ww) { const float2 t = *(const float2*)&TOT[ww * 128 + 2 * lane]; if (ww < w) { off0 *= t.x; off1 *= t.y; } tot0 *= t.x; tot1 *= t.y; }
        if (w == 0) *(float2*)&DL[2 * lane] = make_float2(tot0, tot1);
        float kt0[8], kt1[8];
#pragma unroll
        for (int i = 0; i < 8; ++i) { const float E0 = off0 * e0[i], E1 = off1 * e1[i];
            const float ke0 = (1.0f - h2lo(rf[i])) * __builtin_amdgcn_rcpf(E0), ke1 = (1.0f - h2hi(rf[i])) * __builtin_amdgcn_rcpf(E1);
            kt0[i] = ke0 * tot0; kt1[i] = ke1 * tot1;
            const int t = 8 * w + i;
            *(unsigned*)(QE + t * 288 + qoff) = pkbf(bflo(rq[i]) * E0, bfhi(rq[i]) * E1);
            *(unsigned*)(KE + t * 288 + qoff) = pkbf(ke0, ke1); }
        { unsigned char* r0 = KTT + (2 * lane) * 128; unsigned char* r1 = r0 + 128;
          *(uint2*)(r0 + sc0) = make_uint2(pkbf(kt0[0], kt0[1]), pkbf(kt0[2], kt0[3])); *(uint2*)(r0 + sc1) = make_uint2(pkbf(kt0[4], kt0[5]), pkbf(kt0[6], kt0[7]));
          *(uint2*)(r1 + sc0) = make_uint2(pkbf(kt1[0], kt1[1]), pkbf(kt1[2], kt1[3])); *(uint2*)(r1 + sc1) = make_uint2(pkbf(kt1[4], kt1[5]), pkbf(kt1[6], kt1[7])); }
        { unsigned char* r0 = VT + (2 * lane) * 128; unsigned char* r1 = r0 + 128;
          *(uint2*)(r0 + sc0) = make_uint2((rv[0] & 0xffffu) | (rv[1] << 16), (rv[2] & 0xffffu) | (rv[3] << 16)); *(uint2*)(r0 + sc1) = make_uint2((rv[4] & 0xffffu) | (rv[5] << 16), (rv[6] & 0xffffu) | (rv[7] << 16));
          *(uint2*)(r1 + sc0) = make_uint2((rv[0] >> 16) | (rv[1] & 0xffff0000u), (rv[2] >> 16) | (rv[3] & 0xffff0000u)); *(uint2*)(r1 + sc1) = make_uint2((rv[4] >> 16) | (rv[5] & 0xffff0000u), (rv[6] >> 16) | (rv[7] & 0xffff0000u)); }
        if (c + 1 < 32) HG_PF(c + 1);
        lds_barrier();
        uint4 rz[2]; float4 nba, nbb;
        { const int v8 = (tid & 15) * 8; const bf16_t* zp = (const bf16_t*)(pbase + (size_t)c * 64 * NPROJ * 2) + 3 * 2048 + v8;
          rz[0] = *(const uint4*)(zp + (size_t)(tid >> 4) * NPROJ); rz[1] = *(const uint4*)(zp + (size_t)(32 + (tid >> 4)) * NPROJ);
          nba = *(const float4*)(p.norm_b + h * 128 + v8); nbb = *(const float4*)(p.norm_b + h * 128 + v8 + 4); }
        bf16x8 qf[4][4], kf[2][4];
#pragma unroll
        for (int ti = 0; ti < 4; ++ti)
#pragma unroll
            for (int ks = 0; ks < 4; ++ks) qf[ti][ks] = ldfrag(QE + (16 * ti + fr) * 288 + ks * 64 + kq * 16);
#pragma unroll
        for (int ks = 0; ks < 4; ++ks) kf[0][ks] = ldfrag(KE + fr * 288 + ks * 64 + kq * 16);
        bf16x8 Sb[4];
#pragma unroll
        for (int ks = 0; ks < 4; ++ks) { const f32x4 x = S[2 * ks], y = S[2 * ks + 1];
            const uint4 r = make_uint4(pkbf(x[0], x[1]), pkbf(x[2], x[3]), pkbf(y[0], y[1]), pkbf(y[2], y[3])); Sb[ks] = __builtin_bit_cast(bf16x8, r); }
        f32x4 oacc[4];
#pragma unroll
        for (int ti = 0; ti < 4; ++ti) oacc[ti] = (f32x4){0.f, 0.f, 0.f, 0.f};
#pragma unroll
        for (int ks = 0; ks < 4; ++ks)
#pragma unroll
            for (int ti = 0; ti < 4; ++ti) oacc[ti] = __builtin_amdgcn_mfma_f32_16x16x32_bf16(qf[ti][ks], Sb[ks], oacc[ti], 0, 0, 0);
        uint2 ap[4][4];
#pragma unroll
        for (int ti = 0; ti < 4; ++ti)
#pragma unroll
            for (int si = 0; si < 4; ++si) ap[ti][si] = make_uint2(0u, 0u);
        bf16x8 vf[2], ktf[8][2]; float4 dlv[8];
#pragma unroll
        for (int si = 0; si < 4; ++si) {
            if (si < 3) {
#pragma unroll
                for (int ks = 0; ks < 4; ++ks) kf[(si + 1) & 1][ks] = ldfrag(KE + (16 * (si + 1) + fr) * 288 + ks * 64 + kq * 16); }
            else {
#pragma unroll
                for (int ss = 0; ss < 2; ++ss) vf[ss] = ldfrag(VT + (16 * w + fr) * 128 + (((4 * ss + kq) * 16) ^ (((fr >> 1) & 7) * 16)));
#pragma unroll
                for (int kt = 0; kt < 8; ++kt) dlv[kt] = *(const float4*)&DL[16 * kt + 4 * kq]; }
            f32x4 d[4];
#pragma unroll
            for (int ti = si; ti < 4; ++ti) d[ti] = (f32x4){0.f, 0.f, 0.f, 0.f};
#pragma unroll
            for (int ks = 0; ks < 4; ++ks)
#pragma unroll
                for (int ti = si; ti < 4; ++ti) d[ti] = __builtin_amdgcn_mfma_f32_16x16x32_bf16(kf[si & 1][ks], qf[ti][ks], d[ti], 0, 0, 0);
#pragma unroll
            for (int j = 0; j < 4; ++j) d[si][j] = (4 * kq + j <= fr) ? d[si][j] : 0.f;
#pragma unroll
            for (int ti = si; ti < 4; ++ti) ap[ti][si] = make_uint2(pkbf(d[ti][0], d[ti][1]), pkbf(d[ti][2], d[ti][3])); }
#pragma unroll
        for (int kt = 0; kt < 8; ++kt)
#pragma unroll
            for (int ss = 0; ss < 2; ++ss) ktf[kt][ss] = ldfrag(KTT + (16 * kt + fr) * 128 + (((4 * ss + kq) * 16) ^ (((fr >> 1) & 7) * 16)));
#pragma unroll
        for (int ti = 0; ti < 4; ++ti)
#pragma unroll
            for (int ss = 0; ss < 2; ++ss) if (2 * ss <= ti) { const uint4 r = make_uint4(ap[ti][2 * ss].x, ap[ti][2 * ss].y, ap[ti][2 * ss + 1].x, ap[ti][2 * ss + 1].y);
                oacc[ti] = __builtin_amdgcn_mfma_f32_16x16x32_bf16(__builtin_bit_cast(bf16x8, r), vf[ss], oacc[ti], 0, 0, 0); }
#pragma unroll
        for (int kt = 0; kt < 8; ++kt) { S[kt][0] *= dlv[kt].x; S[kt][1] *= dlv[kt].y; S[kt][2] *= dlv[kt].z; S[kt][3] *= dlv[kt].w; }
#pragma unroll
        for (int ss = 0; ss < 2; ++ss)
#pragma unroll
            for (int kt = 0; kt < 8; ++kt) S[kt] = __builtin_amdgcn_mfma_f32_16x16x32_bf16(ktf[kt][ss], vf[ss], S[kt], 0, 0, 0);
#pragma unroll
        for (int ti = 0; ti < 4; ++ti)
#pragma unroll
            for (int j = 0; j < 4; ++j) OB[(16 * ti + 4 * kq + j) * 128 + 16 * w + fr] = oacc[ti][j];
        lds_barrier();
#pragma unroll
        for (int ps = 0; ps < 2; ++ps) { const int t = ps * 32 + (tid >> 4), v8 = (tid & 15) * 8;
            const float4 oa = *(const float4*)&OB[t * 128 + v8], ob = *(const float4*)&OB[t * 128 + v8 + 4];
            const float o[8] = {oa.x, oa.y, oa.z, oa.w, ob.x, ob.y, ob.z, ob.w}; const float nb[8] = {nba.x, nba.y, nba.z, nba.w, nbb.x, nbb.y, nbb.z, nbb.w}; float z[8]; unpack8(rz[ps], z);
            float ss = 0.f;
#pragma unroll
            for (int j = 0; j < 8; ++j) ss += o[j] * o[j];
            ss = row16_sum(ss);
            const float sc = rsqrtf(ss * (1.0f / 128.0f) + EPSV);
            float y[8];
#pragma unroll
            for (int j = 0; j < 8; ++j) y[j] = o[j] * sc * nb[j] * z[j];
            *(uint4*)(mix + (row0 + (size_t)c * 64 + t) * DMIX + 2048 + h * 128 + v8) = pack8(y); }
    }
#undef HG_PF
    float* sd = p.out + OFF_NHP + ((size_t)(b * 16 + h) * 128 + 4 * kq) * 128 + 16 * w + fr;
#pragma unroll
    for (int kt = 0; kt < 8; ++kt)
#pragma unroll
        for (int j = 0; j < 4; ++j) sd[(size_t)(16 * kt + j) * 128] = S[kt][j];
    lds_barrier();
}

__device__ void hgrn_sample_item(const Params& p, unsigned char* lds, int it) {
    const int h = it & 15, b = it >> 4;
    float* Q = (float*)lds; float* F = Q + 1024; float* Op = F + 1024;
    int tid = threadIdx.x; asm volatile("" : "+v"(tid));
    const int lane = tid & 63, w = tid >> 6;
    const bf16_t* proj = (const bf16_t*)(p.ws + WS_PROJ);
    const size_t soff = (size_t)it * 16384 + (size_t)(16 * w) * 128 + 2 * lane;
    const float* s0 = p.state_hgrn + soff;
    float2 S[16];
#pragma unroll
    for (int j = 0; j < 16; ++j) { const f32x2_t t = __builtin_nontemporal_load((const f32x2_t*)(s0 + j * 128)); S[j] = make_float2(t.x, t.y); }
    const size_t row0 = (size_t)PROWS + (size_t)b * 8;
    float2 vv[8];
#pragma unroll
    for (int t = 0; t < 8; ++t) { const unsigned u = *(const unsigned*)(proj + (row0 + t) * NPROJ + 6 * 2048 + h * 128 + 2 * lane); vv[t] = make_float2(bflo(u), bfhi(u)); }
    if (tid < 128) { const int t = tid >> 4, pk = (tid & 15) * 8;
        const bf16_t* qp = proj + (row0 + t) * NPROJ + 4 * 2048 + h * 128 + pk;
        const uint4 rq = *(const uint4*)qp, rf = *(const uint4*)(qp + 2048);
        float q[8], f[8]; unpack8(rq, q);
        f[0] = h2lo(rf.x); f[1] = h2hi(rf.x); f[2] = h2lo(rf.y); f[3] = h2hi(rf.y); f[4] = h2lo(rf.z); f[5] = h2hi(rf.z); f[6] = h2lo(rf.w); f[7] = h2hi(rf.w);
        *(float4*)&Q[t * 128 + pk] = make_float4(q[0], q[1], q[2], q[3]); *(float4*)&Q[t * 128 + pk + 4] = make_float4(q[4], q[5], q[6], q[7]);
        *(float4*)&F[t * 128 + pk] = make_float4(f[0], f[1], f[2], f[3]); *(float4*)&F[t * 128 + pk + 4] = make_float4(f[4], f[5], f[6], f[7]); }
    lds_barrier();
#pragma unroll
    for (int t = 0; t < 8; ++t) { float2 op = make_float2(0.f, 0.f);
#pragma unroll
        for (int j4 = 0; j4 < 4; ++j4) { const float4 f4 = *(const float4*)&F[t * 128 + 16 * w + j4 * 4], q4 = *(const float4*)&Q[t * 128 + 16 * w + j4 * 4];
            const float ff[4] = {f4.x, f4.y, f4.z, f4.w}, qq[4] = {q4.x, q4.y, q4.z, q4.w};
#pragma unroll
            for (int j = 0; j < 4; ++j) { float2& s = S[j4 * 4 + j]; s.x = ff[j] * (s.x - vv[t].x) + vv[t].x; s.y = ff[j] * (s.y - vv[t].y) + vv[t].y; op.x += s.x * qq[j]; op.y += s.y * qq[j]; } }
        *(float2*)&Op[(w * 8 + t) * 128 + 2 * lane] = op; }
    float* d = p.out + OFF_NHS + soff;
#pragma unroll
    for (int j = 0; j < 16; ++j) { const f32x2_t t = {S[j].x, S[j].y}; __builtin_nontemporal_store(t, (f32x2_t*)(d + j * 128)); }
    lds_barrier();
    { const int idx = tid * 2, t = idx >> 7, v = idx & 127; float2 s = make_float2(0.f, 0.f);
#pragma unroll
      for (int ww = 0; ww < 8; ++ww) { const float2 o = *(const float2*)&Op[(ww * 8 + t) * 128 + v]; s.x += o.x; s.y += o.y; }
      float ss = row16_sum(s.x * s.x + s.y * s.y); ss += __shfl_xor(ss, 16); ss += __shfl_xor(ss, 32);
      const float sc = rsqrtf(ss * (1.0f / 128.0f) + EPSV);
      const float2 nb = *(const float2*)(p.norm_b + h * 128 + v);
      const unsigned zz = *(const unsigned*)(proj + (row0 + t) * NPROJ + 7 * 2048 + h * 128 + v);
      *(unsigned*)((bf16_t*)(p.ws + WS_MIX) + (row0 + t) * DMIX + 2048 + h * 128 + v) = pkbf(s.x * sc * nb.x * bflo(zz), s.y * sc * nb.y * bfhi(zz)); }
    lds_barrier();
}

__device__ void conv_item(const Params& p, int item) {
    int tid = threadIdx.x; asm volatile("" : "+v"(tid));
    const int half = tid >> 8, c0 = (tid & 255) * 8;
    const bf16_t* proj = (const bf16_t*)(p.ws + WS_PROJ);
    bf16_t* mix = (bf16_t*)(p.ws + WS_MIX);
    size_t row0; int t0, L, T; float* ncout; bool sample;
    if (item < 256) { const int g = item * 2 + half; row0 = (size_t)g * 16; const int b = g >> 7; t0 = (g & 127) * 16; L = 16; T = 2048; ncout = p.out + OFF_NCP + (size_t)b * 2 * 2048; sample = false; }
    else { const int s = (item - 256) * 2 + half; row0 = (size_t)PROWS + (size_t)s * 8; t0 = 0; L = 8; T = 8; ncout = p.out + OFF_NCS + (size_t)s * 2 * 2048; sample = true; }
    float w0[8], w1[8], w2[8], na[8], u1[8], u2[8];
    { const float4 a = *(const float4*)(p.conv_w + c0), b = *(const float4*)(p.conv_w + c0 + 4); w0[0] = a.x; w0[1] = a.y; w0[2] = a.z; w0[3] = a.w; w0[4] = b.x; w0[5] = b.y; w0[6] = b.z; w0[7] = b.w; }
    { const float4 a = *(const float4*)(p.conv_w + 2048 + c0), b = *(const float4*)(p.conv_w + 2048 + c0 + 4); w1[0] = a.x; w1[1] = a.y; w1[2] = a.z; w1[3] = a.w; w1[4] = b.x; w1[5] = b.y; w1[6] = b.z; w1[7] = b.w; }
    { const float4 a = *(const float4*)(p.conv_w + 4096 + c0), b = *(const float4*)(p.conv_w + 4096 + c0 + 4); w2[0] = a.x; w2[1] = a.y; w2[2] = a.z; w2[3] = a.w; w2[4] = b.x; w2[5] = b.y; w2[6] = b.z; w2[7] = b.w; }
    { const float4 a = *(const float4*)(p.norm_a + c0), b = *(const float4*)(p.norm_a + c0 + 4); na[0] = a.x; na[1] = a.y; na[2] = a.z; na[3] = a.w; na[4] = b.x; na[5] = b.y; na[6] = b.z; na[7] = b.w; }
    if (sample) { const float* sc = p.state_conv + (size_t)((item - 256) * 2 + half) * 2 * 2048 + c0;
        const float4 a = *(const float4*)sc, b = *(const float4*)(sc + 4), c = *(const float4*)(sc + 2048), d = *(const float4*)(sc + 2048 + 4);
        u2[0] = a.x; u2[1] = a.y; u2[2] = a.z; u2[3] = a.w; u2[4] = b.x; u2[5] = b.y; u2[6] = b.z; u2[7] = b.w;
        u1[0] = c.x; u1[1] = c.y; u1[2] = c.z; u1[3] = c.w; u1[4] = d.x; u1[5] = d.y; u1[6] = d.z; u1[7] = d.w; }
    else if (t0 == 0) {
#pragma unroll
        for (int j = 0; j < 8; ++j) { u1[j] = 0.f; u2[j] = 0.f; } }
    else { const bf16_t* r2 = proj + (row0 - 2) * NPROJ + c0; const bf16_t* r1 = r2 + NPROJ;
        const uint4 v2 = *(const uint4*)r2, cc2 = *(const uint4*)(r2 + 2 * 2048), v1 = *(const uint4*)r1, cc1 = *(const uint4*)(r1 + 2 * 2048);
        float a[8], b[8]; unpack8(v2, a); unpack8(cc2, b);
#pragma unroll
        for (int j = 0; j < 8; ++j) u2[j] = a[j] * b[j];
        unpack8(v1, a); unpack8(cc1, b);
#pragma unroll
        for (int j = 0; j < 8; ++j) u1[j] = a[j] * b[j]; }
    for (int tb = 0; tb < L; tb += 4) {
        uint4 rv[4], rb[4], rc[4], rz[4];
#pragma unroll
        for (int i = 0; i < 4; ++i) { const bf16_t* r = proj + (row0 + tb + i) * NPROJ + c0; rv[i] = ntl16(r); rb[i] = ntl16(r + 2048); rc[i] = ntl16(r + 4096); rz[i] = ntl16(r + 6144); }
#pragma unroll
        for (int i = 0; i < 4; ++i) {
            float v[8], bb[8], cc[8], z[8], u[8], pre[8]; unpack8(rv[i], v); unpack8(rb[i], bb); unpack8(rc[i], cc); unpack8(rz[i], z);
            float ss = 0.f;
#pragma unroll
            for (int j = 0; j < 8; ++j) { u[j] = cc[j] * v[j]; const float cv = w0[j] * u2[j] + w1[j] * u1[j] + w2[j] * u[j]; pre[j] = bb[j] * cv; ss += pre[j] * pre[j]; }
            ss = row16_sum(ss);
            const float sc = rsqrtf(ss * (1.0f / 128.0f) + EPSV);
            float y[8];
#pragma unroll
            for (int j = 0; j < 8; ++j) { y[j] = pre[j] * sc * na[j] * z[j]; u2[j] = u1[j]; u1[j] = u[j]; }
            *(uint4*)(mix + (row0 + tb + i) * DMIX + c0) = pack8(y);
            const int t = t0 + tb + i;
            if (t >= T - 2) { float* d = ncout + (size_t)(t - (T - 2)) * 2048 + c0; *(float4*)d = make_float4(u[0], u[1], u[2], u[3]); *(float4*)(d + 4) = make_float4(u[4], u[5], u[6], u[7]); }
        }
    }
}

__device__ void phase2(const Params& p, unsigned char* lds) {
    unsigned* ctr = (unsigned*)(p.ws + WS_CTR);
    volatile int* slot = (volatile int*)(lds + LDS_STAGE + 16);
    constexpr int N_ITEMS = 64 + 2048 + 320;
    const int tid = threadIdx.x;
#ifdef STATIC_QUEUE
    for (int item = blockIdx.x; item < N_ITEMS; item += gridDim.x) {
        if (item < 64) hgrn_prompt_item(p, lds, item);
        else if (item < 64 + 2048) hgrn_sample_item(p, lds, item - 64);
        else conv_item(p, item - (64 + 2048));
        lds_barrier();
    }
    return;
#endif
    const bool pin = gridDim.x >= 256;
    if (tid == 0) *slot = pin ? ((blockIdx.x < 64) ? (int)blockIdx.x : 64 + (int)atomicAdd(ctr, 1u)) : (int)atomicAdd(ctr, 1u);
    lds_barrier();
    int item = *slot;
    lds_barrier();
    while (item < N_ITEMS) {
        unsigned nxt = 0;
        if (tid == 0) nxt = (pin ? 64u : 0u) + atomicAdd(ctr, 1u);
#ifndef PROBE_ITEM
#define PROBE_ITEM 0
#endif
        const int reps_a = (PROBE_ITEM == 1 && p.ph_hi == 6) ? 2 : 1, reps_b = (PROBE_ITEM == 2 && p.ph_hi == 6) ? 2 : 1, reps_c = (PROBE_ITEM == 3 && p.ph_hi == 6) ? 2 : 1;
        if (item < 64) { for (int r = 0; r < reps_a; ++r) hgrn_prompt_item(p, lds, item); }
        else if (item < 64 + 2048) { for (int r = 0; r < reps_b; ++r) hgrn_sample_item(p, lds, item - 64); }
        else { for (int r = 0; r < reps_c; ++r) conv_item(p, item - (64 + 2048)); }
        if (tid == 0) *slot = (int)nxt;
        lds_barrier();
        item = *slot;
        lds_barrier();
    }
}

__device__ void phase3(const Params& p) {
    const int tid = threadIdx.x, half = tid >> 8, c0 = (tid & 255) * 8;
    const bf16_t* proj = (const bf16_t*)(p.ws + WS_PROJ);
    const float* ows = (const float*)(p.ws + WS_O);
    bf16_t* mix = (bf16_t*)(p.ws + WS_MIX);
    float nb[8];
    { const float4 a = *(const float4*)(p.norm_b + c0), b = *(const float4*)(p.norm_b + c0 + 4); nb[0] = a.x; nb[1] = a.y; nb[2] = a.z; nb[3] = a.w; nb[4] = b.x; nb[5] = b.y; nb[6] = b.z; nb[7] = b.w; }
    for (int base = blockIdx.x * 8; base < MROWS; base += gridDim.x * 8) {
        float4 oa[4], ob[4]; uint4 rz[4];
#pragma unroll
        for (int i = 0; i < 4; ++i) { const size_t r = (size_t)base + half * 4 + i; oa[i] = *(const float4*)(ows + r * DM + c0); ob[i] = *(const float4*)(ows + r * DM + c0 + 4); rz[i] = *(const uint4*)(proj + r * NPROJ + 7 * 2048 + c0); }
#pragma unroll
        for (int i = 0; i < 4; ++i) { const size_t r = (size_t)base + half * 4 + i;
            const float o[8] = {oa[i].x, oa[i].y, oa[i].z, oa[i].w, ob[i].x, ob[i].y, ob[i].z, ob[i].w}; float z[8]; unpack8(rz[i], z);
            float ss = 0.f;
#pragma unroll
            for (int j = 0; j < 8; ++j) ss += o[j] * o[j];
            ss = row16_sum(ss);
            const float sc = rsqrtf(ss * (1.0f / 128.0f) + EPSV);
            float y[8];
#pragma unroll
            for (int j = 0; j < 8; ++j) y[j] = o[j] * sc * nb[j] * z[j];
            *(uint4*)(mix + r * DMIX + 2048 + c0) = pack8(y); }
    }
}

__device__ void phase5(const Params& p, unsigned char* lds) {
    const int tid = threadIdx.x, lane = tid & 63, w = __builtin_amdgcn_readfirstlane(tid >> 6);
    const bf16_t* hws = (const bf16_t*)(p.ws + WS_H);
    float* LG = (float*)lds; float* LB = LG + 2048;
    *(float4*)&LG[tid * 4] = *(const float4*)(p.ln_gain + tid * 4); *(float4*)&LB[tid * 4] = *(const float4*)(p.ln_bias + tid * 4);
    lds_barrier();
    auto fin = [&](float4 (&r)[8], const int row) __attribute__((always_inline)) {
        float s = 0.f;
#pragma unroll
        for (int i = 0; i < 8; ++i) s += (r[i].x + r[i].y) + (r[i].z + r[i].w);
#pragma unroll
        for (int o = 32; o > 0; o >>= 1) s += __shfl_xor(s, o);
        const float mu = s * (1.0f / 2048.0f); float q = 0.f;
#pragma unroll
        for (int i = 0; i < 8; ++i) { r[i].x -= mu; r[i].y -= mu; r[i].z -= mu; r[i].w -= mu; q += (r[i].x * r[i].x + r[i].y * r[i].y) + (r[i].z * r[i].z + r[i].w * r[i].w); }
#pragma unroll
        for (int o = 32; o > 0; o >>= 1) q += __shfl_xor(q, o);
        const float rs = rsqrtf(q * (1.0f / 2048.0f) + EPSV);
        float* yr = p.out + OFF_Y + (size_t)row * DM;
#pragma unroll
        for (int i = 0; i < 8; ++i) { const int col = i * 256 + lane * 4; const float4 g = *(const float4*)&LG[col], bb = *(const float4*)&LB[col];
            const pg8::f32x4 yv = {r[i].x * rs * g.x + bb.x, r[i].y * rs * g.y + bb.y, r[i].z * rs * g.z + bb.z, r[i].w * rs * g.w + bb.w}; __builtin_nontemporal_store(yv, (pg8::f32x4*)(yr + col)); }
    };
    if (w < 4) {
        for (int sr = blockIdx.x * 4 + w; sr < SROWS; sr += gridDim.x * 4) {
            const float* xr = p.x_sample + (size_t)sr * DM;
            const bf16_t* hp = (const bf16_t*)(p.ws + WS_HPART) + (size_t)sr * DM;
            float4 r[8];
#pragma unroll
            for (int i = 0; i < 8; ++i) { const pg8::f32x4 x4 = __builtin_nontemporal_load((const pg8::f32x4*)(xr + i * 256 + lane * 4)); r[i] = make_float4(ALPHA * x4.x, ALPHA * x4.y, ALPHA * x4.z, ALPHA * x4.w); }
#pragma unroll 2
            for (int kp = 0; kp < 8; ++kp) {
#pragma unroll
                for (int i = 0; i < 8; ++i) { const u32x2_t t = __builtin_nontemporal_load((const u32x2_t*)(hp + (size_t)kp * SROWS * DM + i * 256 + lane * 4)); r[i].x += bflo(t.x); r[i].y += bfhi(t.x); r[i].z += bflo(t.y); r[i].w += bfhi(t.y); } }
            fin(r, PROWS + sr);
        }
    }
    const int stride = gridDim.x * 8;
    int row = blockIdx.x * 8 + w;
    while (row < PROWS) {
        int nv = 1;
#pragma unroll
        for (int k = 1; k < 4; ++k) nv += (row + k * stride < PROWS) ? 1 : 0;
        float4 rr[4][8];
#pragma unroll
        for (int k = 0; k < 4; ++k) { const bf16_t* hk = hws + (size_t)(k < nv ? row + k * stride : row) * DM;
#pragma unroll
            for (int i = 0; i < 8; ++i) { const u32x2_t t = __builtin_nontemporal_load((const u32x2_t*)(hk + i * 256 + lane * 4)); rr[k][i] = make_float4(bflo(t.x), bfhi(t.x), bflo(t.y), bfhi(t.y)); } }
#pragma unroll
        for (int k = 0; k < 4; ++k) if (k < nv) fin(rr[k], row + k * stride);
        row += nv * stride;
    }
}


#define XB_TMO      128
#define XB_XCNT(j)  (256  + 64 * (j))
#define XB_XSUB(j)  (1280 + 64 * (j))
#define XB_XGEN(j)  (2304 + 64 * (j))
#define XB_TOP      3328
#define XB_TOPGEN   3392
#define XCD_BAR_WORDS 3456
#define XB_SPIN_CAP (1u << 18)
__device__ __forceinline__ unsigned xb_ld(unsigned* p)              { return __hip_atomic_load(p, __ATOMIC_RELAXED, __HIP_MEMORY_SCOPE_AGENT); }
__device__ __forceinline__ unsigned xb_add(unsigned* p, unsigned v) { return __hip_atomic_fetch_add(p, v, __ATOMIC_RELAXED, __HIP_MEMORY_SCOPE_AGENT); }
__device__ __forceinline__ unsigned xb_xcc_id() { return (unsigned)__builtin_amdgcn_s_getreg((3 << 11) | 20) & 0xFu; }
#define XB_SPIN(cond, bar) do { unsigned _sp = 0; while (cond) { __builtin_amdgcn_s_sleep(1); \
    if ((++_sp & 255u) == 0u) { if (xb_ld(&(bar)[XB_TMO])) break; if (_sp > XB_SPIN_CAP) { atomicAdd(&(bar)[XB_TMO], 1u); break; } } } } while (0)
struct XcdBarrier { unsigned* bar; unsigned x; volatile PG8_LAS unsigned* st; };
__device__ __forceinline__ XcdBarrier xcd_barrier_post(unsigned* bar, volatile PG8_LAS unsigned* st) {
    XcdBarrier b; b.bar = bar; b.x = xb_xcc_id(); b.st = st;
    if (threadIdx.x == 0) (void)xb_add(&bar[XB_XCNT(b.x)], 1u);
    return b;
}
__device__ __forceinline__ void xcd_barrier_complete(unsigned* bar, unsigned x, unsigned& nloc, unsigned& nx) {
    const unsigned G = gridDim.x * gridDim.y * gridDim.z;
    unsigned sum, cnt, mine, sp = 0u;
    for (;;) {
        sum = 0u; cnt = 0u; mine = 0u;
#pragma unroll
        for (unsigned j = 0; j < 16; ++j) { const unsigned c = xb_ld(&bar[XB_XCNT(j)]); sum += c; cnt += (c > 0u) ? 1u : 0u; mine = (j == x) ? c : mine; }
        if (sum == G) break;
        __builtin_amdgcn_s_sleep(1);
        if ((++sp & 255u) == 0u) { if (xb_ld(&bar[XB_TMO])) break; if (sp > XB_SPIN_CAP) { atomicAdd(&bar[XB_TMO], 1u); break; } }
    }
    nloc = mine > 0u ? mine : 1u; nx = cnt > 0u ? cnt : 1u;
}
__device__ __forceinline__ void xcd_barrier(const XcdBarrier& b) {
    asm volatile("s_waitcnt vmcnt(0)" ::: "memory");
    __syncthreads();
    if (threadIdx.x == 0) {
        unsigned* bar = b.bar;
        __builtin_amdgcn_s_waitcnt(0);
        unsigned nloc = b.st[0], nx = b.st[1];
        if (nloc == 0u) { xcd_barrier_complete(bar, b.x, nloc, nx); b.st[0] = nloc; b.st[1] = nx; }
        const unsigned old = xb_add(&bar[XB_XSUB(b.x)], 1u);
        const unsigned gen = old / nloc;
        if (old + 1u == (gen + 1u) * nloc) {
            __builtin_amdgcn_fence(__ATOMIC_RELEASE, "agent");
            asm volatile("s_waitcnt vmcnt(0)" ::: "memory");
            const unsigned og = xb_add(&bar[XB_TOP], 1u);
            const unsigned tg = og / nx;
            if (og + 1u == (tg + 1u) * nx) xb_add(&bar[XB_TOPGEN], 1u);
            else XB_SPIN(xb_ld(&bar[XB_TOPGEN]) == tg, bar);
            __builtin_amdgcn_fence(__ATOMIC_ACQUIRE, "agent");
            xb_add(&bar[XB_XGEN(b.x)], 1u);
            asm volatile("s_waitcnt vmcnt(0)" ::: "memory");
        } else {
            XB_SPIN(xb_ld(&bar[XB_XGEN(b.x)]) == gen, bar);
            __builtin_amdgcn_fence(__ATOMIC_ACQUIRE, "agent");
            asm volatile("s_waitcnt vmcnt(0)" ::: "memory");
        }
    }
    __syncthreads();
}

struct EpiResB {
    static constexpr bool PERM = true, AFTER_DRAIN = false;
    bf16_t* C; int ldc; const float* X;
    __device__ __forceinline__ void operator()(const pg8::f32x4 (&acc)[2][2][4][2], const pg8::Unit& u, int wr, int wc, int fr, int fq) const {
        using namespace pg8;
        const int row0 = u.pm * BM + wr * 64 + fr, col0 = u.pn * BM + wc * 32 + 8 * fq;
#pragma unroll
        for (int ai = 0; ai < 2; ++ai) {
            f32x4 xv[4][2][2];
#pragma unroll
            for (int m = 0; m < 4; ++m) { const float* xp = X + (size_t)(row0 + ai * HALF + m * 16) * ldc + col0;
#pragma unroll
                for (int bj = 0; bj < 2; ++bj)
#pragma unroll
                    for (int n = 0; n < 2; ++n) xv[m][bj][n] = __builtin_nontemporal_load((const f32x4*)(xp + bj * HALF + n * 4)); }
#pragma unroll
            for (int m = 0; m < 4; ++m) { bf16_t* rowp = C + (size_t)(row0 + ai * HALF + m * 16) * ldc + col0;
#pragma unroll
                for (int bj = 0; bj < 2; ++bj) { const f32x4 v0 = acc[ai][bj][m][0] + ALPHA * xv[m][bj][0], v1 = acc[ai][bj][m][1] + ALPHA * xv[m][bj][1];
                    u32x4 wv; wv.x = pkbf(v0[0], v0[1]); wv.y = pkbf(v0[2], v0[3]); wv.z = pkbf(v1[0], v1[1]); wv.w = pkbf(v1[2], v1[3]);
                    *(u32x4*)(rowp + bj * HALF) = wv; } } }
    }
};
struct EpiRes {
    static constexpr bool PERM = false, AFTER_DRAIN = false;
    float* C; int ldc; const float* X;
    __device__ __forceinline__ void operator()(const pg8::f32x4 (&acc)[2][2][4][2], const pg8::Unit& u, int wr, int wc, int fr, int fq) const {
        using namespace pg8;
        const int row0 = u.pm * BM + wr * 64 + fr, col0 = u.pn * BM + wc * 32 + 4 * fq;
#pragma unroll
        for (int ai = 0; ai < 2; ++ai) {
            f32x4 xv[4][2][2];
#pragma unroll
            for (int m = 0; m < 4; ++m) { const float* xp = X + (size_t)(row0 + ai * HALF + m * 16) * ldc + col0;
#pragma unroll
                for (int bj = 0; bj < 2; ++bj)
#pragma unroll
                    for (int n = 0; n < 2; ++n) xv[m][bj][n] = __builtin_nontemporal_load((const f32x4*)(xp + bj * HALF + n * 16)); }
#pragma unroll
            for (int m = 0; m < 4; ++m) { float* rowp = C + (size_t)(row0 + ai * HALF + m * 16) * ldc + col0;
#pragma unroll
                for (int bj = 0; bj < 2; ++bj)
#pragma unroll
                    for (int n = 0; n < 2; ++n) *(f32x4*)(rowp + bj * HALF + n * 16) = acc[ai][bj][m][n] + ALPHA * xv[m][bj][n]; } }
    }
};
struct OneUnit { int pm, pn;
    __device__ bool next(int i, pg8::Unit& u) const { if (i) return false; u.pm = pm; u.pn = pn; return true; }
    __device__ __forceinline__ void a_ready(const pg8::Unit&) const {}
    __device__ __forceinline__ void done(const pg8::Unit&) const {} };
__global__ __launch_bounds__(512, 2) void mega(Params p) {
    extern __shared__ __attribute__((aligned(16))) unsigned char shm[];
    cg::grid_group grid = cg::this_grid();
    if (p.ph_lo < 0) grid.sync();
    const bool fused = p.ph_hi - p.ph_lo > 1;
    volatile PG8_LAS unsigned* st = (volatile PG8_LAS unsigned*)(PG8_LAS unsigned char*)(shm + LDS_STAGE);
    if (threadIdx.x == 0) { st[0] = 0u; st[1] = 0u; }
    __syncthreads();
    XcdBarrier xb; xb.bar = (unsigned*)(p.ws + WS_BAR); xb.x = 0; xb.st = st;
    if (fused) xb = xcd_barrier_post((unsigned*)(p.ws + WS_BAR), st);
#define SEAM() xcd_barrier(xb)
#ifndef PROBE_REP
#define PROBE_REP 0
#endif
#define RUN_PHASE(i, ...) if (p.ph_lo <= (i) && (i) < p.ph_hi) { if ((i) > p.ph_lo) SEAM(); __VA_ARGS__ if ((PROBE_REP >> (i)) & 1) { SEAM(); if ((i) == 2) { if (blockIdx.x == 0 && threadIdx.x == 0) *(unsigned*)(p.ws + WS_CTR) = 0u; SEAM(); } __VA_ARGS__ } }
    RUN_PHASE(0, phase0(p, shm);)
    RUN_PHASE(1, { pg8::Gemm g{(const bf16_t*)(p.ws + WS_A1), (const bf16_t*)(p.ws + WS_BT1), MROWS, NPROJ, DM, DM};
        pg8::StaticOrder S; S.init(MROWS, NPROJ, (int)gridDim.x, (int)blockIdx.x);
        EpiProj E{(bf16_t*)(p.ws + WS_PROJ), p.lb_logits};
        pg8::gemm_phase<EpiProj, pg8::StaticOrder, false>((PG8_LAS unsigned char*)shm, g, S, E, nullptr); })
    RUN_PHASE(2, phase2(p, shm);)
    RUN_PHASE(4, {
        { pg8::Gemm g{(const bf16_t*)(p.ws + WS_MIX), (const bf16_t*)(p.ws + WS_BT2), PROWS, DM, DMIX, DMIX};
          pg8::StaticOrder S; S.init(PROWS, DM, (int)gridDim.x, (int)blockIdx.x);
          EpiResB E{(bf16_t*)(p.ws + WS_H), DM, p.x_prompt};
          pg8::gemm_phase<EpiResB, pg8::StaticOrder, false>((PG8_LAS unsigned char*)shm, g, S, E, nullptr); }
        for (int q = blockIdx.x; q < 256; q += gridDim.x) { const int kp = q & 7, tile = q >> 3;
          __syncthreads();
          pg8::Gemm g{(const bf16_t*)(p.ws + WS_MIX) + (size_t)PROWS * DMIX + kp * 512, (const bf16_t*)(p.ws + WS_BT2) + kp * 512, SROWS, DM, 512, DMIX};
          OneUnit S{tile >> 3, tile & 7};
          pg8::EpiBf16<0> E{(bf16_t*)(p.ws + WS_HPART) + (size_t)kp * SROWS * DM, DM, nullptr, 0, 0};
          pg8::gemm_phase<pg8::EpiBf16<0>, OneUnit, false>((PG8_LAS unsigned char*)shm, g, S, E, nullptr); } })
    RUN_PHASE(5, phase5(p, shm);)
#ifdef PROBE_SYNC
    for (int i = 0; i < PROBE_SYNC; ++i) SEAM();
#endif
#undef RUN_PHASE
}

#ifndef N_LAUNCHES
#define N_LAUNCHES 1
#endif
extern "C" void kernel_launch(void* const* d_in, const int* in_sizes, int n_in, void* d_out, int out_size, void* d_ws, size_t ws_size, hipStream_t stream) {
    static int grid = 0;
    if (grid == 0) {
        if (n_in != 12 || ws_size < WS_END) { fprintf(stderr, "kernel_launch: unexpected shapes (n_in %d, ws %zu < %zu)\n", n_in, ws_size, (size_t)WS_END); grid = -1; return; }
        int dev = 0, cus = 0, per_cu = 0;
        hipGetDevice(&dev); hipDeviceGetAttribute(&cus, hipDeviceAttributeMultiprocessorCount, dev);
        if (hipFuncSetAttribute((const void*)mega, hipFuncAttributeMaxDynamicSharedMemorySize, LDS_BYTES) != hipSuccess) { fprintf(stderr, "kernel_launch: hipFuncSetAttribute failed\n"); grid = -1; return; }
        if (hipOccupancyMaxActiveBlocksPerMultiprocessor(&per_cu, (const void*)mega, 512, LDS_BYTES) != hipSuccess || per_cu < 1) { fprintf(stderr, "kernel_launch: occupancy query says %d\n", per_cu); per_cu = 1; }
        (void)hipGetLastError();
        grid = cus * 1;
        if (grid <= 0) grid = 256;
    }
    if (grid < 0) return;
    Params p{};
    p.x_prompt = (const float*)d_in[0]; p.x_sample = (const float*)d_in[1]; p.state_conv = (const float*)d_in[2]; p.state_hgrn = (const float*)d_in[3];
    p.w_in = (const float*)d_in[4]; p.conv_w = (const float*)d_in[5]; p.norm_a = (const float*)d_in[6]; p.lb_logits = (const float*)d_in[7]; p.norm_b = (const float*)d_in[8];
    p.w_out = (const float*)d_in[9]; p.ln_gain = (const float*)d_in[10]; p.ln_bias = (const float*)d_in[11];
    p.out = (float*)d_out; p.ws = (unsigned char*)d_ws;
    (void)hipMemsetAsync((unsigned char*)d_ws + WS_CTR, 0, WS_END - WS_CTR, stream);
#if N_LAUNCHES == 1
    p.ph_lo = 0; p.ph_hi = 6;
    void* args[] = {&p};
    hipError_t e = hipLaunchCooperativeKernel((const void*)mega, dim3(grid), dim3(512), args, LDS_BYTES, stream);
    if (e != hipSuccess) fprintf(stderr, "cooperative launch failed: %s (grid %d)\n", hipGetErrorString(e), grid);
#else
    for (int i = 0; i < 6; ++i) { p.ph_lo = i; p.ph_hi = i + 1; hipLaunchKernelGGL(mega, dim3(grid), dim3(512), LDS_BYTES, stream, p); }
#endif
}
```

```cpp
#include <hip/hip_runtime.h>
namespace pg8 {
#define PG8_LAS __attribute__((address_space(3)))
typedef unsigned short bf16_t;
typedef short bf16x8 __attribute__((ext_vector_type(8)));
typedef float f32x4 __attribute__((ext_vector_type(4)));
typedef unsigned u32x4 __attribute__((ext_vector_type(4)));
constexpr int BM = 256, BK = 64, HALF = 128, HTB = HALF * BK * 2  , STAGE_BYTES = 8 * HTB, NXCD = 8, WGM = 8;

__host__ __device__ __forceinline__ int lds_byte(int r, int c) { const int st = (r >> 4) * 2 + (c >> 5), rr = r & 15, cc = c & 31, ob = rr * 64 + cc * 2; return st * 1024 + (ob ^ (((ob >> 9) & 1) << 5)); }
__host__ __device__ __forceinline__ void stage_rc(int b, int& R, int& C) { const int st = b / 1024, sb = b % 1024, swz = sb ^ (((sb >> 9) & 1) << 5); R = (st >> 1) * 16 + swz / 64; C = (st & 1) * 32 + (swz % 64) / 2; }
__host__ __device__ __forceinline__ int perm32(int rho) { const int n = rho >> 4, i = rho & 15; return 8 * (i >> 2) + 4 * n + (i & 3); }

struct Unit { int pm, pn; };
struct Gemm { const bf16_t* A; const bf16_t* Bt; int M, N, K, ld; };

struct StaticOrder {
    int nM, nN, nwg, G, c;
    __host__ __device__ void init(int M, int N, int G_, int c_) { nM = M / BM; nN = N / BM; nwg = nM * nN; G = G_; c = c_; }
    __host__ __device__ bool next(int i, Unit& u) const {
        const long L = (long)i * G + c; if (L >= nwg) return false;
        int wgid = (int)L; { const int q = nwg / NXCD, r = nwg % NXCD, xcd = wgid % NXCD, off = wgid / NXCD; wgid = (xcd < r ? xcd * (q + 1) : r * (q + 1) + (xcd - r) * q) + off; }
        const int nig = WGM * nN, gid = wgid / nig, fm = gid * WGM, gsz = (nM - fm) < WGM ? (nM - fm) : WGM;
        u.pm = fm + ((wgid % nig) % gsz); u.pn = (wgid % nig) / gsz; return true;
    }
    __device__ __forceinline__ void a_ready(const Unit&) const {}
    __device__ __forceinline__ void done(const Unit&) const {}
};
__device__ __forceinline__ unsigned cvt_pk_bf16(float lo, float hi) { unsigned r; asm volatile("v_cvt_pk_bf16_f32 %0, %1, %2" : "=v"(r) : "v"(lo), "v"(hi)); return r; }
typedef float f32x2 __attribute__((ext_vector_type(2)));
__device__ __forceinline__ f32x2 gelu_pk(f32x2 v) {
    const f32x2 av = __builtin_elementwise_abs(v), d = av * 0.2316418882f + 1.0f;
    f32x2 t; t.x = __builtin_amdgcn_rcpf(d.x); t.y = __builtin_amdgcn_rcpf(d.y);
    f32x2 q = t * 0.5307027145f + (-0.7265760135f); q = q * t + 0.7107068705f; q = q * t + (-0.142248368f); q = q * t + 0.127414796f; q = q * t;
    const f32x2 s = (v * v) * (-0.72134752044f);
    f32x2 e; e.x = __builtin_amdgcn_exp2f(s.x); e.y = __builtin_amdgcn_exp2f(s.y);
    const f32x2 m = v * (q * e), r = v - m;
    f32x2 o; o.x = v.x < 0.f ? m.x : r.x; o.y = v.y < 0.f ? m.y : r.y; return o;
}

struct EpiF32 {
    static constexpr bool PERM = false, AFTER_DRAIN = false;
    float* C; int ldc; const float* bias;
    __device__ __forceinline__ void operator()(const f32x4 (&acc)[2][2][4][2], const Unit& u, int wr, int wc, int fr, int fq) const {
        const int row0 = u.pm * BM + wr * 64 + fr, col0 = u.pn * BM + wc * 32 + 4 * fq;
        f32x4 bv[2][2];
#pragma unroll
        for (int bj = 0; bj < 2; ++bj)
#pragma unroll
            for (int n = 0; n < 2; ++n) bv[bj][n] = bias ? *(const f32x4*)(bias + col0 + bj * HALF + n * 16) : (f32x4){0.f, 0.f, 0.f, 0.f};
#pragma unroll
        for (int ai = 0; ai < 2; ++ai)
#pragma unroll
            for (int m = 0; m < 4; ++m) { float* rowp = C + (size_t)(row0 + ai * HALF + m * 16) * ldc + col0;
#pragma unroll
                for (int bj = 0; bj < 2; ++bj)
#pragma unroll
                    for (int n = 0; n < 2; ++n) *(f32x4*)(rowp + bj * HALF + n * 16) = acc[ai][bj][m][n] + bv[bj][n]; }
    }
};
template <int ACT  > struct EpiBf16 {
    static constexpr bool PERM = true, AFTER_DRAIN = false;
    bf16_t* O; int ldc; const float* bias; int split_cols; size_t split_stride;
    __device__ __forceinline__ void operator()(const f32x4 (&acc)[2][2][4][2], const Unit& u, int wr, int wc, int fr, int fq) const {
        const int row0 = u.pm * BM + wr * 64 + fr; int colt = u.pn * BM; bf16_t* base = O;
        if (split_cols) { const int t = colt / split_cols; base += (size_t)t * split_stride; colt -= t * split_cols; }
        const int col0 = colt + wc * 32 + 8 * fq, bcol0 = u.pn * BM + wc * 32 + 8 * fq;
        f32x4 bv[2][2];
#pragma unroll
        for (int bj = 0; bj < 2; ++bj)
#pragma unroll
            for (int n = 0; n < 2; ++n) bv[bj][n] = bias ? *(const f32x4*)(bias + bcol0 + bj * HALF + 4 * n) : (f32x4){0.f, 0.f, 0.f, 0.f};
#pragma unroll
        for (int ai = 0; ai < 2; ++ai)
#pragma unroll
            for (int m = 0; m < 4; ++m) { bf16_t* rowp = base + (size_t)(row0 + ai * HALF + m * 16) * ldc + col0;
#pragma unroll
                for (int bj = 0; bj < 2; ++bj) { f32x4 v0 = acc[ai][bj][m][0] + bv[bj][0], v1 = acc[ai][bj][m][1] + bv[bj][1];
                    if (ACT == 1) { f32x2 a = gelu_pk((f32x2){v0[0], v0[1]}), b = gelu_pk((f32x2){v0[2], v0[3]}), c = gelu_pk((f32x2){v1[0], v1[1]}), d = gelu_pk((f32x2){v1[2], v1[3]});
                        v0 = (f32x4){a.x, a.y, b.x, b.y}; v1 = (f32x4){c.x, c.y, d.x, d.y}; }
                    if (ACT == 2) {
#pragma unroll
                        for (int j = 0; j < 4; ++j) { v0[j] = 0.5f * v0[j] * (1.0f + erff(v0[j] * 0.70710678f)); v1[j] = 0.5f * v1[j] * (1.0f + erff(v1[j] * 0.70710678f)); } }
                    u32x4 w; w.x = cvt_pk_bf16(v0[0], v0[1]); w.y = cvt_pk_bf16(v0[2], v0[3]); w.z = cvt_pk_bf16(v1[0], v1[1]); w.w = cvt_pk_bf16(v1[2], v1[3]);
                    *(u32x4*)(rowp + bj * HALF) = w; } }
    }
};

template <class Epi, class Sched, bool STAMP = false>
__device__ __forceinline__ void gemm_phase(PG8_LAS unsigned char* lds, const Gemm g, const Sched& S, const Epi& E, unsigned long long* stamps) {
    const int tid = threadIdx.x, wid = __builtin_amdgcn_readfirstlane(tid >> 6), lane = tid & 63, wr = wid >> 2, wc = wid & 3, fr = lane & 15, fq = lane >> 4;
    const int K = g.ld, nt = g.K / BK;
    int ts_lo = 0, ts_hi = 0, nts = 0; const unsigned long long rt_entry = STAMP ? (unsigned long long)wall_clock64() : 0ull;
#define PG8_STAMP() do { if (STAMP && wid == 0 && nts < 64) { const unsigned long long _c = (unsigned long long)clock64(); \
        ts_lo = (lane == nts) ? (int)(unsigned)_c : ts_lo; ts_hi = (lane == nts) ? (int)(unsigned)(_c >> 32) : ts_hi; ++nts; } } while (0)
    PG8_STAMP();
    unsigned voffA[2], voffB[2];
#pragma unroll
    for (int i = 0; i < 2; ++i) { int R, C; stage_rc(tid * 16 + i * 8192, R, C); const int Rb = Epi::PERM ? ((R & ~31) + perm32(R & 31)) : R;
        voffA[i] = (unsigned)(R * K + C) * 2u; voffB[i] = (unsigned)(Rb * K + C) * 2u; }
    const size_t kstep = (size_t)(BK * 2);
    const size_t hstep = (size_t)HALF * K * 2;
    const size_t tstep = 2 * hstep;
    const unsigned ldsw = (unsigned)wid * 1024u;
    const int aoff = lds_byte(wr * 64 + fr, fq * 8), boff = lds_byte(wc * 32 + fr, fq * 8);
#define PG8_SA(b, h) (((b) * 2 + (h)) * HTB)
#define PG8_SB(b, h) ((4 + (b) * 2 + (h)) * HTB)
#define PG8_STAGE(bufoff, gbase, voff) do { _Pragma("unroll") for (int _i = 0; _i < 2; ++_i) \
        __builtin_amdgcn_global_load_lds((const unsigned*)((const char*)(gbase) + (voff)[_i]), (PG8_LAS unsigned*)(lds + (bufoff) + ldsw + _i * 8192), 16, 0, 0); } while (0)
#define PG8_LDA(dst, b, h) do { _Pragma("unroll") for (int m = 0; m < 4; ++m) _Pragma("unroll") for (int k = 0; k < 2; ++k) dst[m][k] = *(const PG8_LAS bf16x8*)(lds + PG8_SA(b, h) + aoff + m * 2048 + k * 1024); } while (0)
#define PG8_LDB(dst, b, h) do { _Pragma("unroll") for (int n = 0; n < 2; ++n) _Pragma("unroll") for (int k = 0; k < 2; ++k) dst[n][k] = *(const PG8_LAS bf16x8*)(lds + PG8_SB(b, h) + boff + n * 2048 + k * 1024); } while (0)
#define PG8_MMA(ai, bj, At, Bt) do { __builtin_amdgcn_s_setprio(1); _Pragma("unroll") for (int m = 0; m < 4; ++m) _Pragma("unroll") for (int n = 0; n < 2; ++n) _Pragma("unroll") for (int k = 0; k < 2; ++k) \
        acc[ai][bj][m][n] = __builtin_amdgcn_mfma_f32_16x16x32_bf16(Bt[n][k], At[m][k], acc[ai][bj][m][n], 0, 0, 0); __builtin_amdgcn_s_setprio(0); } while (0)
#define PG8_WAIT_V(n) asm volatile("s_waitcnt vmcnt(" #n ")" ::: "memory")
#define PG8_WAIT_L(n) asm volatile("s_waitcnt lgkmcnt(" #n ")" ::: "memory")
#define PG8_BAR __builtin_amdgcn_s_barrier()
#define PG8_SCHED __builtin_amdgcn_sched_barrier(0)
    Unit cur, nxt; int ui = 0;
    if (!S.next(0, cur)) return;
    f32x4 acc[2][2][4][2];
#pragma unroll
    for (int a = 0; a < 2; ++a)
#pragma unroll
        for (int b = 0; b < 2; ++b)
#pragma unroll
            for (int m = 0; m < 4; ++m)
#pragma unroll
                for (int n = 0; n < 2; ++n) acc[a][b][m][n] = (f32x4){0.f, 0.f, 0.f, 0.f};
    bf16x8 At[4][2], B0[2][2], B1[2][2];
    const char* cA = (const char*)g.A + (size_t)cur.pm * tstep; const char* cB = (const char*)g.Bt + (size_t)cur.pn * tstep;
    S.a_ready(cur);
    PG8_STAGE(PG8_SB(0, 0), cB, voffB); PG8_STAGE(PG8_SA(0, 0), cA, voffA); PG8_STAGE(PG8_SB(0, 1), cB + hstep, voffB); PG8_STAGE(PG8_SA(0, 1), cA + hstep, voffA);
    if (wr == 1) PG8_BAR;
    PG8_WAIT_V(4); PG8_BAR;
    PG8_STAGE(PG8_SB(1, 0), cB + kstep, voffB); PG8_STAGE(PG8_SA(1, 0), cA + kstep, voffA); PG8_STAGE(PG8_SB(1, 1), cB + hstep + kstep, voffB);
    PG8_WAIT_V(6); PG8_BAR;
    PG8_STAMP();
    for (;;) {
        const bool has_next = S.next(ui + 1, nxt);
        const char* nA = has_next ? (const char*)g.A + (size_t)nxt.pm * tstep : cA; const char* nB = has_next ? (const char*)g.Bt + (size_t)nxt.pn * tstep : cB;
        for (int t = 0; t < nt; t += 2) {
            const bool last = (t == nt - 2);
            const char* a1 = cA + (size_t)(t + 1) * kstep;
            const char* a2 = last ? nA : cA + (size_t)(t + 2) * kstep; const char* b2 = last ? nB : cB + (size_t)(t + 2) * kstep;
            const char* a3 = a2 + kstep; const char* b3 = b2 + kstep;
            if (last && has_next) S.a_ready(nxt);
            PG8_LDB(B0, 0, 0); PG8_SCHED; PG8_LDA(At, 0, 0); PG8_STAGE(PG8_SA(1, 1), a1 + hstep, voffA);
            PG8_WAIT_L(8); PG8_BAR; PG8_WAIT_L(0); PG8_MMA(0, 0, At, B0); PG8_BAR; PG8_SCHED;
            PG8_LDB(B1, 0, 1); PG8_STAGE(PG8_SB(0, 0), b2, voffB);
            PG8_BAR; PG8_WAIT_L(0); PG8_MMA(0, 1, At, B1); PG8_BAR;
            PG8_LDA(At, 0, 1); PG8_STAGE(PG8_SA(0, 0), a2, voffA);
            PG8_BAR; PG8_WAIT_L(0); PG8_MMA(1, 0, At, B0); PG8_BAR; PG8_SCHED;
            PG8_STAGE(PG8_SB(0, 1), b2 + hstep, voffB);
            PG8_WAIT_V(6); PG8_BAR; PG8_MMA(1, 1, At, B1); PG8_BAR;
            PG8_LDB(B0, 1, 0); PG8_SCHED; PG8_LDA(At, 1, 0); PG8_STAGE(PG8_SA(0, 1), a2 + hstep, voffA);
            PG8_WAIT_L(8); PG8_BAR; PG8_WAIT_L(0); PG8_MMA(0, 0, At, B0); PG8_BAR; PG8_SCHED;
            PG8_LDB(B1, 1, 1); PG8_STAGE(PG8_SB(1, 0), b3, voffB);
            PG8_BAR; PG8_WAIT_L(0); PG8_MMA(0, 1, At, B1); PG8_BAR;
            PG8_LDA(At, 1, 1); PG8_STAGE(PG8_SA(1, 0), a3, voffA);
            PG8_BAR; PG8_WAIT_L(0); PG8_MMA(1, 0, At, B0); PG8_BAR; PG8_SCHED;
            PG8_STAGE(PG8_SB(1, 1), b3 + hstep, voffB);
            PG8_WAIT_V(6); PG8_BAR; PG8_MMA(1, 1, At, B1); PG8_BAR;
        }
        PG8_STAMP();
        if constexpr (!Epi::AFTER_DRAIN) { E(acc, cur, wr, wc, fr, fq); S.done(cur); }
        PG8_STAMP();
        if (!has_next) break;
#pragma unroll
        for (int a = 0; a < 2; ++a)
#pragma unroll
            for (int b = 0; b < 2; ++b)
#pragma unroll
                for (int m = 0; m < 4; ++m)
#pragma unroll
                    for (int n = 0; n < 2; ++n) acc[a][b][m][n] = (f32x4){0.f, 0.f, 0.f, 0.f};
        cur = nxt; cA = nA; cB = nB; ++ui;
    }
    PG8_WAIT_V(0);
    if (wr == 0) PG8_BAR;
    PG8_BAR;
    if constexpr (Epi::AFTER_DRAIN) { E.fused(acc, cur, wr, wc, fr, fq, lds, wid, lane); S.done(cur); }
    PG8_STAMP();
    if (STAMP && wid == 0) { stamps[lane] = lane < nts ? (((unsigned long long)(unsigned)ts_hi << 32) | (unsigned)ts_lo) : 0ull;
        if (lane == 62) stamps[62] = rt_entry; if (lane == 63) stamps[63] = (unsigned long long)wall_clock64(); }
#undef PG8_STAMP
#undef PG8_SA
#undef PG8_SB
#undef PG8_STAGE
#undef PG8_LDA
#undef PG8_LDB
#undef PG8_MMA
#undef PG8_WAIT_V
#undef PG8_WAIT_L
#undef PG8_BAR
#undef PG8_SCHED
}
}

#include <cstdio>
#include <ctime>
#include <cstdlib>
#include <cstring>
#include <cmath>
#include <vector>
#include <algorithm>
#define CK(x) do { hipError_t e_ = (x); if (e_ != hipSuccess) { fprintf(stderr, "HIP %s:%d %s\n", __FILE__, __LINE__, hipGetErrorString(e_)); exit(2); } } while (0)
#include <hip/hip_cooperative_groups.h>
#include <cstdio>
namespace cg = cooperative_groups;
using pg8::bf16_t;
typedef float f32x2_t __attribute__((ext_vector_type(2)));
typedef unsigned u32x2_t __attribute__((ext_vector_type(2)));
typedef __bf16 bf16x2_t __attribute__((ext_vector_type(2)));
__device__ __forceinline__ unsigned pkbf(float lo, float hi) { const f32x2_t v = {lo, hi}; const bf16x2_t r = __builtin_convertvector(v, bf16x2_t); return __builtin_bit_cast(unsigned, r); }

constexpr int DM = 2048, NPROJ = 16384, DMIX = 4096;
constexpr int PROWS = 8192, SROWS = 1024, MROWS = 9216;
constexpr int LDS_STAGE = 131072, LDS_BYTES = LDS_STAGE + 64;
constexpr float EPSV = 1e-5f;
constexpr float ALPHA = 1.189207115002721f;
constexpr float QSCALE = 0.08838834764831845f;

constexpr size_t WS_A1 = 0;
constexpr size_t WS_BT1 = WS_A1 + (size_t)MROWS * DM * 2;
constexpr size_t WS_O = 0;
constexpr size_t WS_BT2 = WS_BT1 + (size_t)NPROJ * DM * 2;
constexpr size_t WS_PROJ = WS_BT2 + (size_t)DM * DMIX * 2;
constexpr size_t WS_H = WS_PROJ;
constexpr size_t WS_HPART = WS_H + (size_t)MROWS * DM * 4;
constexpr size_t WS_MIX = WS_PROJ + (size_t)MROWS * NPROJ * 2;
constexpr size_t WS_CTR = WS_MIX + (size_t)MROWS * DMIX * 2;
constexpr size_t WS_BAR = WS_CTR + 256;
constexpr size_t WS_END = WS_BAR + 3456 * 4;

constexpr size_t OFF_Y = 0;
constexpr size_t OFF_NCP = (size_t)MROWS * DM;
constexpr size_t OFF_NHP = OFF_NCP + 4 * 2 * 2048;
constexpr size_t OFF_NCS = OFF_NHP + (size_t)4 * 16 * 128 * 128;
constexpr size_t OFF_NHS = OFF_NCS + (size_t)128 * 2 * 2048;

struct Params {
    const float* x_prompt; const float* x_sample; const float* state_conv; const float* state_hgrn;
    const float* w_in; const float* conv_w; const float* norm_a; const float* lb_logits; const float* norm_b;
    const float* w_out; const float* ln_gain; const float* ln_bias;
    float* out; unsigned char* ws;
    int ph_lo, ph_hi;
};

__device__ __forceinline__ float bflo(unsigned u) { return __uint_as_float(u << 16); }
__device__ __forceinline__ float bfhi(unsigned u) { return __uint_as_float(u & 0xffff0000u); }
__device__ __forceinline__ void unpack8(const uint4 r, float (&f)[8]) {
    f[0] = bflo(r.x); f[1] = bfhi(r.x); f[2] = bflo(r.y); f[3] = bfhi(r.y); f[4] = bflo(r.z); f[5] = bfhi(r.z); f[6] = bflo(r.w); f[7] = bfhi(r.w);
}
__device__ __forceinline__ uint4 pack8(const float (&f)[8]) {
    uint4 r; r.x = pkbf(f[0], f[1]); r.y = pkbf(f[2], f[3]); r.z = pkbf(f[4], f[5]); r.w = pkbf(f[6], f[7]); return r;
}
__device__ __forceinline__ uint4 ntl16(const void* p) { const pg8::u32x4 t = __builtin_nontemporal_load((const pg8::u32x4*)p); return make_uint4(t.x, t.y, t.z, t.w); }
__device__ __forceinline__ float sigm(float x) { return 1.0f / (1.0f + __expf(-x)); }
__device__ __forceinline__ float silu(float x) { return x / (1.0f + __expf(-x)); }
__device__ __forceinline__ void lds_barrier() { asm volatile("s_waitcnt lgkmcnt(0)" ::: "memory"); __builtin_amdgcn_s_barrier(); asm volatile("" ::: "memory"); }
#define DPP_ROR(x, n) __builtin_bit_cast(float, __builtin_amdgcn_update_dpp(0, __builtin_bit_cast(int, (x)), 0x120 + (n), 0xF, 0xF, true))
__device__ __forceinline__ float row16_sum(float x) { x += DPP_ROR(x, 8); x += DPP_ROR(x, 4); x += DPP_ROR(x, 2); x += DPP_ROR(x, 1); return x; }


typedef _Float16 h16x2 __attribute__((ext_vector_type(2)));
__device__ __forceinline__ unsigned pack_h2(float a, float b) { const h16x2 v = {(_Float16)a, (_Float16)b}; return __builtin_bit_cast(unsigned, v); }
__device__ __forceinline__ float h2lo(unsigned u) { return (float)__builtin_bit_cast(h16x2, u)[0]; }
__device__ __forceinline__ float h2hi(unsigned u) { return (float)__builtin_bit_cast(h16x2, u)[1]; }
__device__ __forceinline__ float ex2(float x) { return __builtin_amdgcn_exp2f(x); }

struct EpiProj {
    static constexpr bool PERM = true, AFTER_DRAIN = false;
    bf16_t* O; const float* lbl;
    __device__ __forceinline__ void operator()(const pg8::f32x4 (&acc)[2][2][4][2], const pg8::Unit& u, int wr, int wc, int fr, int fq) const {
        using namespace pg8;
        const int row0 = u.pm * BM + wr * 64 + fr, seg = u.pn >> 3, col0 = u.pn * BM + wc * 32 + 8 * fq;
        if (seg == 5) {
            float lb[2][8];
#pragma unroll
            for (int bj = 0; bj < 2; ++bj) { const float* l0 = lbl + (col0 - 5 * 2048) + bj * HALF; const float* l1 = l0 + 2048;
                const f32x4 a0 = *(const f32x4*)l0, a1 = *(const f32x4*)(l0 + 4), b0 = *(const f32x4*)l1, b1 = *(const f32x4*)(l1 + 4);
#pragma unroll
                for (int j = 0; j < 4; ++j) { lb[bj][j] = 1.0f / (1.0f + __expf(b0[j] - a0[j])); lb[bj][4 + j] = 1.0f / (1.0f + __expf(b1[j] - a1[j])); } }
#pragma unroll
            for (int ai = 0; ai < 2; ++ai)
#pragma unroll
                for (int m = 0; m < 4; ++m) { const size_t row = (size_t)(row0 + ai * HALF + m * 16);
#pragma unroll
                    for (int bj = 0; bj < 2; ++bj) { const f32x4 v0 = acc[ai][bj][m][0], v1 = acc[ai][bj][m][1];
                        float g[8];
#pragma unroll
                        for (int j = 0; j < 4; ++j) { g[j] = lb[bj][j] + (1.0f - lb[bj][j]) * sigm(v0[j]); g[4 + j] = lb[bj][4 + j] + (1.0f - lb[bj][4 + j]) * sigm(v1[j]); }
                        u32x4 wg; wg.x = pack_h2(g[0], g[1]); wg.y = pack_h2(g[2], g[3]); wg.z = pack_h2(g[4], g[5]); wg.w = pack_h2(g[6], g[7]);
                        *(u32x4*)(O + row * NPROJ + col0 + bj * HALF) = wg; } }
        } else {
            const bool act = (seg == 3) | (seg == 4) | (seg == 7); const float sc = seg == 4 ? QSCALE : 1.0f;
#pragma unroll
            for (int ai = 0; ai < 2; ++ai)
#pragma unroll
                for (int m = 0; m < 4; ++m) { bf16_t* rowp = O + (size_t)(row0 + ai * HALF + m * 16) * NPROJ + col0;
#pragma unroll
                    for (int bj = 0; bj < 2; ++bj) { f32x4 v0 = acc[ai][bj][m][0], v1 = acc[ai][bj][m][1];
                        if (act) {
#pragma unroll
                            for (int j = 0; j < 4; ++j) { v0[j] = silu(v0[j]) * sc; v1[j] = silu(v1[j]) * sc; } }
                        u32x4 w; w.x = pkbf(v0[0], v0[1]); w.y = pkbf(v0[2], v0[3]); w.z = pkbf(v1[0], v1[1]); w.w = pkbf(v1[2], v1[3]);
                        *(u32x4*)(rowp + bj * HALF) = w; } }
        }
    }
};

__device__ __forceinline__ void p0_tile_info(const Params& p, int tile, const float*& src, int& ld, bf16_t*& dst, int& ldd) {
    if (tile < 2048) { const int kt = tile >> 6, nt = tile & 63; src = p.w_in + (size_t)(kt * 64) * NPROJ + nt * 256; ld = NPROJ;
        dst = (bf16_t*)(p.ws + WS_BT1) + (size_t)(nt * 256) * DM + kt * 64; ldd = DM; }
    else { const int t2 = tile - 2048, kt = t2 >> 3, nt = t2 & 7; src = p.w_out + (size_t)(kt * 64) * DM + nt * 256; ld = DM;
        dst = (bf16_t*)(p.ws + WS_BT2) + (size_t)(nt * 256) * DMIX + kt * 64; ldd = DMIX; }
}
__device__ void phase0(const Params& p, unsigned char* lds) {
    float* T = (float*)lds;
    const int tid = threadIdx.x;
    if (blockIdx.x == 0 && tid == 0) *(unsigned*)(p.ws + WS_CTR) = 0u;
    constexpr int NT = 2048 + 512;
    pg8::f32x4 r[8];
    int tile = blockIdx.x;
    const float* src = nullptr; int ld = 0; bf16_t* dst = nullptr; int ldd = 0;
    p0_tile_info(p, tile < NT ? tile : NT - 1, src, ld, dst, ldd);
#pragma unroll
    for (int i = 0; i < 8; ++i) r[i] = __builtin_nontemporal_load((const pg8::f32x4*)(src + (size_t)(i * 8 + (tid >> 6)) * ld + (tid & 63) * 4));
    while (tile < NT) {
#pragma unroll
        for (int i = 0; i < 8; ++i) { const int k = i * 8 + (tid >> 6), n = (tid & 63) * 4; *(pg8::f32x4*)&T[k * 256 + (n ^ (i << 3))] = r[i]; }
        bf16_t* cdst = dst; const int cldd = ldd;
        const int nxt = tile + gridDim.x;
        p0_tile_info(p, nxt < NT ? nxt : NT - 1, src, ld, dst, ldd);
#pragma unroll
        for (int i = 0; i < 8; ++i) r[i] = __builtin_nontemporal_load((const pg8::f32x4*)(src + (size_t)(i * 8 + (tid >> 6)) * ld + (tid & 63) * 4));
        lds_barrier();
#pragma unroll
        for (int c = 0; c < 4; ++c) { const int q = tid + 512 * c, n = q >> 3, k8 = q & 7; float v[8];
#pragma unroll
            for (int j = 0; j < 8; ++j) v[j] = T[(k8 * 8 + j) * 256 + (n ^ (k8 << 3))];
            *(uint4*)(cdst + (size_t)n * cldd + k8 * 8) = pack8(v); }
        lds_barrier();
        tile = nxt;
    }
    bf16_t* A1 = (bf16_t*)(p.ws + WS_A1);
    constexpr size_t total8 = (size_t)MROWS * DM / 8, pe = (size_t)PROWS * DM;
    const size_t stride = (size_t)gridDim.x * 512;
    for (size_t i = (size_t)blockIdx.x * 512 + tid; i < total8; i += 3 * stride) {
        const size_t i0 = i, i1 = i + stride, i2 = i + 2 * stride;
        const size_t j1 = i1 < total8 ? i1 : i0, j2 = i2 < total8 ? i2 : i0;
        const size_t e0 = i0 * 8, e1 = j1 * 8, e2 = j2 * 8;
        const float* s0 = e0 < pe ? p.x_prompt + e0 : p.x_sample + (e0 - pe);
        const float* s1 = e1 < pe ? p.x_prompt + e1 : p.x_sample + (e1 - pe);
        const float* s2 = e2 < pe ? p.x_prompt + e2 : p.x_sample + (e2 - pe);
        const pg8::f32x4 a0 = __builtin_nontemporal_load((const pg8::f32x4*)s0), b0 = __builtin_nontemporal_load((const pg8::f32x4*)(s0 + 4)), a1 = __builtin_nontemporal_load((const pg8::f32x4*)s1), b1 = __builtin_nontemporal_load((const pg8::f32x4*)(s1 + 4)), a2 = __builtin_nontemporal_load((const pg8::f32x4*)s2), b2 = __builtin_nontemporal_load((const pg8::f32x4*)(s2 + 4));
        { const float v[8] = {a0.x, a0.y, a0.z, a0.w, b0.x, b0.y, b0.z, b0.w}; *(uint4*)(A1 + e0) = pack8(v); }
        if (i1 < total8) { const float v[8] = {a1.x, a1.y, a1.z, a1.w, b1.x, b1.y, b1.z, b1.w}; *(uint4*)(A1 + e1) = pack8(v); }
        if (i2 < total8) { const float v[8] = {a2.x, a2.y, a2.z, a2.w, b2.x, b2.y, b2.z, b2.w}; *(uint4*)(A1 + e2) = pack8(v); }
    }
}

__device__ __forceinline__ pg8::bf16x8 ldfrag(const unsigned char* p) { const uint4 r = *(const uint4*)p; return __builtin_bit_cast(pg8::bf16x8, r); }
__device__ void hgrn_prompt_item(const Params& p, unsigned char* lds, int it) {
    using pg8::bf16x8; using pg8::f32x4;
    const int h = it & 15, b = it >> 4;
    unsigned char* QE = lds; unsigned char* KE = lds + 18432; unsigned char* KTT = lds + 36864; unsigned char* VT = lds + 57344;
    float* TOT = (float*)(lds + 77824); float* DL = (float*)(lds + 81920); float* OB = (float*)(lds + 82432);
    int tid = threadIdx.x; asm volatile("" : "+v"(tid));
    const int lane = tid & 63, w = tid >> 6, fr = lane & 15, kq = lane >> 4;
    const size_t row0 = (size_t)b * 2048;
    bf16_t* mix = (bf16_t*)(p.ws + WS_MIX);
    const char* pbase = (const char*)(p.ws + WS_PROJ) + (row0 * NPROJ + 4 * 2048 + h * 128) * 2;
    const int m16 = lane & 15;
    const int qoff = (32 * (lane >> 4) + 8 * ((m16 & 7) >> 1) + 4 * (m16 >> 3) + 2 * (m16 & 1)) * 2;
    const int sc0 = ((4 * (w >> 2) + 2 * (w & 1)) ^ (lane & 7)) * 16 + 8 * ((w >> 1) & 1), sc1 = ((4 * (w >> 2) + 2 * (w & 1) + 1) ^ (lane & 7)) * 16 + 8 * ((w >> 1) & 1);
    const unsigned voff = (unsigned)((8 * w * NPROJ + 2 * lane) * 2);
    unsigned rq[8], rf[8], rv[8];
#define HG_PF(c) do { const char* cb = pbase + (size_t)(c) * 64 * NPROJ * 2; _Pragma("unroll") for (int i = 0; i < 8; ++i) { const char* ri = cb + (size_t)i * NPROJ * 2; \
        rq[i] = *(const unsigned*)(ri + voff); rf[i] = *(const unsigned*)(ri + 4096 + voff); rv[i] = *(const unsigned*)(ri + 8192 + voff); } } while (0)
    HG_PF(0);
    f32x4 S[8];
#pragma unroll
    for (int i = 0; i < 8; ++i) S[i] = (f32x4){0.f, 0.f, 0.f, 0.f};
    for (int c = 0; c < 32; ++c) {
        float e0[8], e1[8]; float a0 = 1.f, a1 = 1.f;
#pragma unroll
        for (int i = 0; i < 8; ++i) { a0 *= h2lo(rf[i]); a1 *= h2hi(rf[i]); e0[i] = a0; e1[i] = a1; }
        *(float2*)&TOT[w * 128 + 2 * lane] = make_float2(a0, a1);
        lds_barrier();
        float off0 = 1.f, off1 = 1.f, tot0 = 1.f, tot1 = 1.f;
#pragma unroll
        for (int ww = 0; ww < 8; ++ww) { const float2 t = *(const float2*)&TOT[ww * 128 + 2 * lane]; if (ww < w) { off0 *= t.x; off1 *= t.y; } tot0 *= t.x; tot1 *= t.y; }
        if (w == 0) *(float2*)&DL[2 * lane] = make_float2(tot0, tot1);
        float kt0[8], kt1[8];
#pragma unroll
        for (int i = 0; i < 8; ++i) { const float E0 = off0 * e0[i], E1 = off1 * e1[i];
            const float ke0 = (1.0f - h2lo(rf[i])) * __builtin_amdgcn_rcpf(E0), ke1 = (1.0f - h2hi(rf[i])) * __builtin_amdgcn_rcpf(E1);
            kt0[i] = ke0 * tot0; kt1[i] = ke1 * tot1;
            const int t = 8 * w + i;
            *(unsigned*)(QE + t * 288 + qoff) = pkbf(bflo(rq[i]) * E0, bfhi(rq[i]) * E1);
            *(unsigned*)(KE + t * 288 + qoff) = pkbf(ke0, ke1); }
        { unsigned char* r0 = KTT + (2 * lane) * 128; unsigned char* r1 = r0 + 128;
          *(uint2*)(r0 + sc0) = make_uint2(pkbf(kt0[0], kt0[1]), pkbf(kt0[2], kt0[3])); *(uint2*)(r0 + sc1) = make_uint2(pkbf(kt0[4], kt0[5]), pkbf(kt0[6], kt0[7]));
          *(uint2*)(r1 + sc0) = make_uint2(pkbf(kt1[0], kt1[1]), pkbf(kt1[2], kt1[3])); *(uint2*)(r1 + sc1) = make_uint2(pkbf(kt1[4], kt1[5]), pkbf(kt1[6], kt1[7])); }
        { unsigned char* r0 = VT + (2 * lane) * 128; unsigned char* r1 = r0 + 128;
          *(uint2*)(r0 + sc0) = make_uint2((rv[0] & 0xffffu) | (rv[1] << 16), (rv[2] & 0xffffu) | (rv[3] << 16)); *(uint2*)(r0 + sc1) = make_uint2((rv[4] & 0xffffu) | (rv[5] << 16), (rv[6] & 0xffffu) | (rv[7] << 16));
          *(uint2*)(r1 + sc0) = make_uint2((rv[0] >> 16) | (rv[1] & 0xffff0000u), (rv[2] >> 16) | (rv[3] & 0xffff0000u)); *(uint2*)(r1 + sc1) = make_uint2((rv[4] >> 16) | (rv[5] & 0xffff0000u), (rv[6] >> 16) | (rv[7] & 0xffff0000u)); }
        if (c + 1 < 32) HG_PF(c + 1);
        lds_barrier();
        uint4 rz[2]; float4 nba, nbb;
        { const int v8 = (tid & 15) * 8; const bf16_t* zp = (const bf16_t*)(pbase + (size_t)c * 64 * NPROJ * 2) + 3 * 2048 + v8;
          rz[0] = *(const uint4*)(zp + (size_t)(tid >> 4) * NPROJ); rz[1] = *(const uint4*)(zp + (size_t)(32 + (tid >> 4)) * NPROJ);
          nba = *(const float4*)(p.norm_b + h * 128 + v8); nbb = *(const float4*)(p.norm_b + h * 128 + v8 + 4); }
        bf16x8 qf[4][4], kf[2][4];
#pragma unroll
        for (int ti = 0; ti < 4; ++ti)
#pragma unroll
            for (int ks = 0; ks < 4; ++ks) qf[ti][ks] = ldfrag(QE + (16 * ti + fr) * 288 + ks * 64 + kq * 16);
#pragma unroll
        for (int ks = 0; ks < 4; ++ks) kf[0][ks] = ldfrag(KE + fr * 288 + ks * 64 + kq * 16);
        bf16x8 Sb[4];
#pragma unroll
        for (int ks = 0; ks < 4; ++ks) { const f32x4 x = S[2 * ks], y = S[2 * ks + 1];
            const uint4 r = make_uint4(pkbf(x[0], x[1]), pkbf(x[2], x[3]), pkbf(y[0], y[1]), pkbf(y[2], y[3])); Sb[ks] = __builtin_bit_cast(bf16x8, r); }
        f32x4 oacc[4];
#pragma unroll
        for (int ti = 0; ti < 4; ++ti) oacc[ti] = (f32x4){0.f, 0.f, 0.f, 0.f};
#pragma unroll
        for (int ks = 0; ks < 4; ++ks)
#pragma unroll
            for (int ti = 0; ti < 4; ++ti) oacc[ti] = __builtin_amdgcn_mfma_f32_16x16x32_bf16(qf[ti][ks], Sb[ks], oacc[ti], 0, 0, 0);
        uint2 ap[4][4];
#pragma unroll
        for (int ti = 0; ti < 4; ++ti)
#pragma unroll
            for (int si = 0; si < 4; ++si) ap[ti][si] = make_uint2(0u, 0u);
        bf16x8 vf[2], ktf[8][2]; float4 dlv[8];
#pragma unroll
        for (int si = 0; si < 4; ++si) {
            if (si < 3) {
#pragma unroll
                for (int ks = 0; ks < 4; ++ks) kf[(si + 1) & 1][ks] = ldfrag(KE + (16 * (si + 1) + fr) * 288 + ks * 64 + kq * 16); }
            else {
#pragma unroll
                for (int ss = 0; ss < 2; ++ss) vf[ss] = ldfrag(VT + (16 * w + fr) * 128 + (((4 * ss + kq) * 16) ^ (((fr >> 1) & 7) * 16)));
#pragma unroll
                for (int kt = 0; kt < 8; ++kt) dlv[kt] = *(const float4*)&DL[16 * kt + 4 * kq]; }
            f32x4 d[4];
#pragma unroll
            for (int ti = si; ti < 4; ++ti) d[ti] = (f32x4){0.f, 0.f, 0.f, 0.f};
#pragma unroll
            for (int ks = 0; ks < 4; ++ks)
#pragma unroll
                for (int ti = si; ti < 4; ++ti) d[ti] = __builtin_amdgcn_mfma_f32_16x16x32_bf16(kf[si & 1][ks], qf[ti][ks], d[ti], 0, 0, 0);
#pragma unroll
            for (int j = 0; j < 4; ++j) d[si][j] = (4 * kq + j <= fr) ? d[si][j] : 0.f;
#pragma unroll
            for (int ti = si; ti < 4; ++ti) ap[ti][si] = make_uint2(pkbf(d[ti][0], d[ti][1]), pkbf(d[ti][2], d[ti][3])); }
#pragma unroll
        for (int kt = 0; kt < 8; ++kt)
#pragma unroll
            for (int ss = 0; ss < 2; ++ss) ktf[kt][ss] = ldfrag(KTT + (16 * kt + fr) * 128 + (((4 * ss + kq) * 16) ^ (((fr >> 1) & 7) * 16)));
#pragma unroll
        for (int ti = 0; ti < 4; ++ti)
#pragma unroll
            for (int ss = 0; ss < 2; ++ss) if (2 * ss <= ti) { const uint4 r = make_uint4(ap[ti][2 * ss].x, ap[ti][2 * ss].y, ap[ti][2 * ss + 1].x, ap[ti][2 * ss + 1].y);
                oacc[ti] = __builtin_amdgcn_mfma_f32_16x16x32_bf16(__builtin_bit_cast(bf16x8, r), vf[ss], oacc[ti], 0, 0, 0); }
#pragma unroll
        for (int kt = 0; kt < 8; ++kt) { S[kt][0] *= dlv[kt].x; S[kt][1] *= dlv[kt].y; S[kt][2] *= dlv[kt].z; S[kt][3] *= dlv[kt].w; }
#pragma unroll
        for (int ss = 0; ss < 2; ++ss)
#pragma unroll
            for (int kt = 0; kt < 8; ++kt) S[kt] = __builtin_amdgcn_mfma_f32_16x16x32_bf16(ktf[kt][ss], vf[ss], S[kt], 0, 0, 0);
#pragma unroll
        for (int ti = 0; ti < 4; ++ti)
#pragma unroll
            for (int j = 0; j < 4; ++j) OB[(16 * ti + 4 * kq + j) * 128 + 16 * w + fr] = oacc[ti][j];
        lds_barrier();
#pragma unroll
        for (int ps = 0; ps < 2; ++ps) { const int t = ps * 32 + (tid >> 4), v8 = (tid & 15) * 8;
            const float4 oa = *(const float4*)&OB[t * 128 + v8], ob = *(const float4*)&OB[t * 128 + v8 + 4];
            const float o[8] = {oa.x, oa.y, oa.z, oa.w, ob.x, ob.y, ob.z, ob.w}; const float nb[8] = {nba.x, nba.y, nba.z, nba.w, nbb.x, nbb.y, nbb.z, nbb.w}; float z[8]; unpack8(rz[ps], z);
            float ss = 0.f;
#pragma unroll
            for (int j = 0; j < 8; ++j) ss += o[j] * o[j];
            ss = row16_sum(ss);
            const float sc = rsqrtf(ss * (1.0f / 128.0f) + EPSV);
            float y[8];
#pragma unroll
            for (int j = 0; j < 8; ++j) y[j] = o[j] * sc * nb[j] * z[j];
            *(uint4*)(mix + (row0 + (size_t)c * 64 + t) * DMIX + 2048 + h * 128 + v8) = pack8(y); }
    }
#undef HG_PF
    float* sd = p.out + OFF_NHP + ((size_t)(b * 16 + h) * 128 + 4 * kq) * 128 + 16 * w + fr;
#pragma unroll
    for (int kt = 0; kt < 8; ++kt)
#pragma unroll
        for (int j = 0; j < 4; ++j) sd[(size_t)(16 * kt + j) * 128] = S[kt][j];
    lds_barrier();
}

__device__ void hgrn_sample_item(const Params& p, unsigned char* lds, int it) {
    const int h = it & 15, b = it >> 4;
    float* Q = (float*)lds; float* F = Q + 1024; float* Op = F + 1024;
    int tid = threadIdx.x; asm volatile("" : "+v"(tid));
    const int lane = tid & 63, w = tid >> 6;
    const bf16_t* proj = (const bf16_t*)(p.ws + WS_PROJ);
    const size_t soff = (size_t)it * 16384 + (size_t)(16 * w) * 128 + 2 * lane;
    const float* s0 = p.state_hgrn + soff;
    float2 S[16];
#pragma unroll
    for (int j = 0; j < 16; ++j) { const f32x2_t t = __builtin_nontemporal_load((const f32x2_t*)(s0 + j * 128)); S[j] = make_float2(t.x, t.y); }
    const size_t row0 = (size_t)PROWS + (size_t)b * 8;
    float2 vv[8];
#pragma unroll
    for (int t = 0; t < 8; ++t) { const unsigned u = *(const unsigned*)(proj + (row0 + t) * NPROJ + 6 * 2048 + h * 128 + 2 * lane); vv[t] = make_float2(bflo(u), bfhi(u)); }
    if (tid < 128) { const int t = tid >> 4, pk = (tid & 15) * 8;
        const bf16_t* qp = proj + (row0 + t) * NPROJ + 4 * 2048 + h * 128 + pk;
        const uint4 rq = *(const uint4*)qp, rf = *(const uint4*)(qp + 2048);
        float q[8], f[8]; unpack8(rq, q);
        f[0] = h2lo(rf.x); f[1] = h2hi(rf.x); f[2] = h2lo(rf.y); f[3] = h2hi(rf.y); f[4] = h2lo(rf.z); f[5] = h2hi(rf.z); f[6] = h2lo(rf.w); f[7] = h2hi(rf.w);
        *(float4*)&Q[t * 128 + pk] = make_float4(q[0], q[1], q[2], q[3]); *(float4*)&Q[t * 128 + pk + 4] = make_float4(q[4], q[5], q[6], q[7]);
        *(float4*)&F[t * 128 + pk] = make_float4(f[0], f[1], f[2], f[3]); *(float4*)&F[t * 128 + pk + 4] = make_float4(f[4], f[5], f[6], f[7]); }
    lds_barrier();
#pragma unroll
    for (int t = 0; t < 8; ++t) { float2 op = make_float2(0.f, 0.f);
#pragma unroll
        for (int j4 = 0; j4 < 4; ++j4) { const float4 f4 = *(const float4*)&F[t * 128 + 16 * w + j4 * 4], q4 = *(const float4*)&Q[t * 128 + 16 * w + j4 * 4];
            const float ff[4] = {f4.x, f4.y, f4.z, f4.w}, qq[4] = {q4.x, q4.y, q4.z, q4.w};
#pragma unroll
            for (int j = 0; j < 4; ++j) { float2& s = S[j4 * 4 + j]; s.x = ff[j] * (s.x - vv[t].x) + vv[t].x; s.y = ff[j] * (s.y - vv[t].y) + vv[t].y; op.x += s.x * qq[j]; op.y += s.y * qq[j]; } }
        *(float2*)&Op[(w * 8 + t) * 128 + 2 * lane] = op; }
    float* d = p.out + OFF_NHS + soff;
#pragma unroll
    for (int j = 0; j < 16; ++j) { const f32x2_t t = {S[j].x, S[j].y}; __builtin_nontemporal_store(t, (f32x2_t*)(d + j * 128)); }
    lds_barrier();
    { const int idx = tid * 2, t = idx >> 7, v = idx & 127; float2 s = make_float2(0.f, 0.f);
#pragma unroll
      for (int ww = 0; ww < 8; ++ww) { const float2 o = *(const float2*)&Op[(ww * 8 + t) * 128 + v]; s.x += o.x; s.y += o.y; }
      float ss = row16_sum(s.x * s.x + s.y * s.y); ss += __shfl_xor(ss, 16); ss += __shfl_xor(ss, 32);
      const float sc = rsqrtf(ss * (1.0f / 128.0f) + EPSV);
      const float2 nb = *(const float2*)(p.norm_b + h * 128 + v);
      const unsigned zz = *(const unsigned*)(proj + (row0 + t) * NPROJ + 7 * 2048 + h * 128 + v);
      *(unsigned*)((bf16_t*)(p.ws + WS_MIX) + (row0 + t) * DMIX + 2048 + h * 128 + v) = pkbf(s.x * sc * nb.x * bflo(zz), s.y * sc * nb.y * bfhi(zz)); }
    lds_barrier();
}

__device__ void conv_item(const Params& p, int item) {
    int tid = threadIdx.x; asm volatile("" : "+v"(tid));
    const int half = tid >> 8, c0 = (tid & 255) * 8;
    const bf16_t* proj = (const bf16_t*)(p.ws + WS_PROJ);
    bf16_t* mix = (bf16_t*)(p.ws + WS_MIX);
    size_t row0; int t0, L, T; float* ncout; bool sample;
    if (item < 256) { const int g = item * 2 + half; row0 = (size_t)g * 16; const int b = g >> 7; t0 = (g & 127) * 16; L = 16; T = 2048; ncout = p.out + OFF_NCP + (size_t)b * 2 * 2048; sample = false; }
    else { const int s = (item - 256) * 2 + half; row0 = (size_t)PROWS + (size_t)s * 8; t0 = 0; L = 8; T = 8; ncout = p.out + OFF_NCS + (size_t)s * 2 * 2048; sample = true; }
    float w0[8], w1[8], w2[8], na[8], u1[8], u2[8];
    { const float4 a = *(const float4*)(p.conv_w + c0), b = *(const float4*)(p.conv_w + c0 + 4); w0[0] = a.x; w0[1] = a.y; w0[2] = a.z; w0[3] = a.w; w0[4] = b.x; w0[5] = b.y; w0[6] = b.z; w0[7] = b.w; }
    { const float4 a = *(const float4*)(p.conv_w + 2048 + c0), b = *(const float4*)(p.conv_w + 2048 + c0 + 4); w1[0] = a.x; w1[1] = a.y; w1[2] = a.z; w1[3] = a.w; w1[4] = b.x; w1[5] = b.y; w1[6] = b.z; w1[7] = b.w; }
    { const float4 a = *(const float4*)(p.conv_w + 4096 + c0), b = *(const float4*)(p.conv_w + 4096 + c0 + 4); w2[0] = a.x; w2[1] = a.y; w2[2] = a.z; w2[3] = a.w; w2[4] = b.x; w2[5] = b.y; w2[6] = b.z; w2[7] = b.w; }
    { const float4 a = *(const float4*)(p.norm_a + c0), b = *(const float4*)(p.norm_a + c0 + 4); na[0] = a.x; na[1] = a.y; na[2] = a.z; na[3] = a.w; na[4] = b.x; na[5] = b.y; na[6] = b.z; na[7] = b.w; }
    if (sample) { const float* sc = p.state_conv + (size_t)((item - 256) * 2 + half) * 2 * 2048 + c0;
        const float4 a = *(const float4*)sc, b = *(const float4*)(sc + 4), c = *(const float4*)(sc + 2048), d = *(const float4*)(sc + 2048 + 4);
        u2[0] = a.x; u2[1] = a.y; u2[2] = a.z; u2[3] = a.w; u2[4] = b.x; u2[5] = b.y; u2[6] = b.z; u2[7] = b.w;
        u1[0] = c.x; u1[1] = c.y; u1[2] = c.z; u1[3] = c.w; u1[4] = d.x; u1[5] = d.y; u1[6] = d.z; u1[7] = d.w; }
    else if (t0 == 0) {
#pragma unroll
        for (int j = 0; j < 8; ++j) { u1[j] = 0.f; u2[j] = 0.f; } }
    else { const bf16_t* r2 = proj + (row0 - 2) * NPROJ + c0; const bf16_t* r1 = r2 + NPROJ;
        const uint4 v2 = *(const uint4*)r2, cc2 = *(const uint4*)(r2 + 2 * 2048), v1 = *(const uint4*)r1, cc1 = *(const uint4*)(r1 + 2 * 2048);
        float a[8], b[8]; unpack8(v2, a); unpack8(cc2, b);
#pragma unroll
        for (int j = 0; j < 8; ++j) u2[j] = a[j] * b[j];
        unpack8(v1, a); unpack8(cc1, b);
#pragma unroll
        for (int j = 0; j < 8; ++j) u1[j] = a[j] * b[j]; }
    for (int tb = 0; tb < L; tb += 4) {
        uint4 rv[4], rb[4], rc[4], rz[4];
#pragma unroll
        for (int i = 0; i < 4; ++i) { const bf16_t* r = proj + (row0 + tb + i) * NPROJ + c0; rv[i] = ntl16(r); rb[i] = ntl16(r + 2048); rc[i] = ntl16(r + 4096); rz[i] = ntl16(r + 6144); }
#pragma unroll
        for (int i = 0; i < 4; ++i) {
            float v[8], bb[8], cc[8], z[8], u[8], pre[8]; unpack8(rv[i], v); unpack8(rb[i], bb); unpack8(rc[i], cc); unpack8(rz[i], z);
            float ss = 0.f;
#pragma unroll
            for (int j = 0; j < 8; ++j) { u[j] = cc[j] * v[j]; const float cv = w0[j] * u2[j] + w1[j] * u1[j] + w2[j] * u[j]; pre[j] = bb[j] * cv; ss += pre[j] * pre[j]; }
            ss = row16_sum(ss);
            const float sc = rsqrtf(ss * (1.0f / 128.0f) + EPSV);
            float y[8];
#pragma unroll
            for (int j = 0; j < 8; ++j) { y[j] = pre[j] * sc * na[j] * z[j]; u2[j] = u1[j]; u1[j] = u[j]; }
            *(uint4*)(mix + (row0 + tb + i) * DMIX + c0) = pack8(y);
            const int t = t0 + tb + i;
            if (t >= T - 2) { float* d = ncout + (size_t)(t - (T - 2)) * 2048 + c0; *(float4*)d = make_float4(u[0], u[1], u[2], u[3]); *(float4*)(d + 4) = make_float4(u[4], u[5], u[6], u[7]); }
        }
    }
}

__device__ void phase2(const Params& p, unsigned char* lds) {
    unsigned* ctr = (unsigned*)(p.ws + WS_CTR);
    volatile int* slot = (volatile int*)(lds + LDS_STAGE + 16);
    constexpr int N_ITEMS = 64 + 2048 + 320;
    const int tid = threadIdx.x;
#ifdef STATIC_QUEUE
    for (int item = blockIdx.x; item < N_ITEMS; item += gridDim.x) {
        if (item < 64) hgrn_prompt_item(p, lds, item);
        else if (item < 64 + 2048) hgrn_sample_item(p, lds, item - 64);
        else conv_item(p, item - (64 + 2048));
        lds_barrier();
    }
    return;
#endif
    const bool pin = gridDim.x >= 256;
    if (tid == 0) *slot = pin ? ((blockIdx.x < 64) ? (int)blockIdx.x : 64 + (int)atomicAdd(ctr, 1u)) : (int)atomicAdd(ctr, 1u);
    lds_barrier();
    int item = *slot;
    lds_barrier();
    while (item < N_ITEMS) {
        unsigned nxt = 0;
        if (tid == 0) nxt = (pin ? 64u : 0u) + atomicAdd(ctr, 1u);
#ifndef PROBE_ITEM
#define PROBE_ITEM 0
#endif
        const int reps_a = (PROBE_ITEM == 1 && p.ph_hi == 6) ? 2 : 1, reps_b = (PROBE_ITEM == 2 && p.ph_hi == 6) ? 2 : 1, reps_c = (PROBE_ITEM == 3 && p.ph_hi == 6) ? 2 : 1;
        if (item < 64) { for (int r = 0; r < reps_a; ++r) hgrn_prompt_item(p, lds, item); }
        else if (item < 64 + 2048) { for (int r = 0; r < reps_b; ++r) hgrn_sample_item(p, lds, item - 64); }
        else { for (int r = 0; r < reps_c; ++r) conv_item(p, item - (64 + 2048)); }
        if (tid == 0) *slot = (int)nxt;
        lds_barrier();
        item = *slot;
        lds_barrier();
    }
}

__device__ void phase3(const Params& p) {
    const int tid = threadIdx.x, half = tid >> 8, c0 = (tid & 255) * 8;
    const bf16_t* proj = (const bf16_t*)(p.ws + WS_PROJ);
    const float* ows = (const float*)(p.ws + WS_O);
    bf16_t* mix = (bf16_t*)(p.ws + WS_MIX);
    float nb[8];
    { const float4 a = *(const float4*)(p.norm_b + c0), b = *(const float4*)(p.norm_b + c0 + 4); nb[0] = a.x; nb[1] = a.y; nb[2] = a.z; nb[3] = a.w; nb[4] = b.x; nb[5] = b.y; nb[6] = b.z; nb[7] = b.w; }
    for (int base = blockIdx.x * 8; base < MROWS; base += gridDim.x * 8) {
        float4 oa[4], ob[4]; uint4 rz[4];
#pragma unroll
        for (int i = 0; i < 4; ++i) { const size_t r = (size_t)base + half * 4 + i; oa[i] = *(const float4*)(ows + r * DM + c0); ob[i] = *(const float4*)(ows + r * DM + c0 + 4); rz[i] = *(const uint4*)(proj + r * NPROJ + 7 * 2048 + c0); }
#pragma unroll
        for (int i = 0; i < 4; ++i) { const size_t r = (size_t)base + half * 4 + i;
            const float o[8] = {oa[i].x, oa[i].y, oa[i].z, oa[i].w, ob[i].x, ob[i].y, ob[i].z, ob[i].w}; float z[8]; unpack8(rz[i], z);
            float ss = 0.f;
#pragma unroll
            for (int j = 0; j < 8; ++j) ss += o[j] * o[j];
            ss = row16_sum(ss);
            const float sc = rsqrtf(ss * (1.0f / 128.0f) + EPSV);
            float y[8];
#pragma unroll
            for (int j = 0; j < 8; ++j) y[j] = o[j] * sc * nb[j] * z[j];
            *(uint4*)(mix + r * DMIX + 2048 + c0) = pack8(y); }
    }
}

__device__ void phase5(const Params& p, unsigned char* lds) {
    const int tid = threadIdx.x, lane = tid & 63, w = __builtin_amdgcn_readfirstlane(tid >> 6);
    const bf16_t* hws = (const bf16_t*)(p.ws + WS_H);
    float* LG = (float*)lds; float* LB = LG + 2048;
    *(float4*)&LG[tid * 4] = *(const float4*)(p.ln_gain + tid * 4); *(float4*)&LB[tid * 4] = *(const float4*)(p.ln_bias + tid * 4);
    lds_barrier();
    auto fin = [&](float4 (&r)[8], const int row) __attribute__((always_inline)) {
        float s = 0.f;
#pragma unroll
        for (int i = 0; i < 8; ++i) s += (r[i].x + r[i].y) + (r[i].z + r[i].w);
#pragma unroll
        for (int o = 32; o > 0; o >>= 1) s += __shfl_xor(s, o);
        const float mu = s * (1.0f / 2048.0f); float q = 0.f;
#pragma unroll
        for (int i = 0; i < 8; ++i) { r[i].x -= mu; r[i].y -= mu; r[i].z -= mu; r[i].w -= mu; q += (r[i].x * r[i].x + r[i].y * r[i].y) + (r[i].z * r[i].z + r[i].w * r[i].w); }
#pragma unroll
        for (int o = 32; o > 0; o >>= 1) q += __shfl_xor(q, o);
        const float rs = rsqrtf(q * (1.0f / 2048.0f) + EPSV);
        float* yr = p.out + OFF_Y + (size_t)row * DM;
#pragma unroll
        for (int i = 0; i < 8; ++i) { const int col = i * 256 + lane * 4; const float4 g = *(const float4*)&LG[col], bb = *(const float4*)&LB[col];
            const pg8::f32x4 yv = {r[i].x * rs * g.x + bb.x, r[i].y * rs * g.y + bb.y, r[i].z * rs * g.z + bb.z, r[i].w * rs * g.w + bb.w}; __builtin_nontemporal_store(yv, (pg8::f32x4*)(yr + col)); }
    };
    if (w < 4) {
        for (int sr = blockIdx.x * 4 + w; sr < SROWS; sr += gridDim.x * 4) {
            const float* xr = p.x_sample + (size_t)sr * DM;
            const bf16_t* hp = (const bf16_t*)(p.ws + WS_HPART) + (size_t)sr * DM;
            float4 r[8];
#pragma unroll
            for (int i = 0; i < 8; ++i) { const pg8::f32x4 x4 = __builtin_nontemporal_load((const pg8::f32x4*)(xr + i * 256 + lane * 4)); r[i] = make_float4(ALPHA * x4.x, ALPHA * x4.y, ALPHA * x4.z, ALPHA * x4.w); }
#pragma unroll 4
            for (int kp = 0; kp < 8; ++kp) {
#pragma unroll
                for (int i = 0; i < 8; ++i) { const u32x2_t t = __builtin_nontemporal_load((const u32x2_t*)(hp + (size_t)kp * SROWS * DM + i * 256 + lane * 4)); r[i].x += bflo(t.x); r[i].y += bfhi(t.x); r[i].z += bflo(t.y); r[i].w += bfhi(t.y); } }
            fin(r, PROWS + sr);
        }
    }
    const int stride = gridDim.x * 8;
    int row = blockIdx.x * 8 + w;
    while (row < PROWS) {
        int nv = 1;
#pragma unroll
        for (int k = 1; k < 4; ++k) nv += (row + k * stride < PROWS) ? 1 : 0;
        float4 rr[4][8];
#pragma unroll
        for (int k = 0; k < 4; ++k) { const bf16_t* hk = hws + (size_t)(k < nv ? row + k * stride : row) * DM;
#pragma unroll
            for (int i = 0; i < 8; ++i) { const u32x2_t t = __builtin_nontemporal_load((const u32x2_t*)(hk + i * 256 + lane * 4)); rr[k][i] = make_float4(bflo(t.x), bfhi(t.x), bflo(t.y), bfhi(t.y)); } }
#pragma unroll
        for (int k = 0; k < 4; ++k) if (k < nv) fin(rr[k], row + k * stride);
        row += nv * stride;
    }
}


#define XB_TMO      128
#define XB_XCNT(j)  (256  + 64 * (j))
#define XB_XSUB(j)  (1280 + 64 * (j))
#define XB_XGEN(j)  (2304 + 64 * (j))
#define XB_TOP      3328
#define XB_TOPGEN   3392
#define XCD_BAR_WORDS 3456
#define XB_SPIN_CAP (1u << 18)
__device__ __forceinline__ unsigned xb_ld(unsigned* p)              { return __hip_atomic_load(p, __ATOMIC_RELAXED, __HIP_MEMORY_SCOPE_AGENT); }
__device__ __forceinline__ unsigned xb_add(unsigned* p, unsigned v) { return __hip_atomic_fetch_add(p, v, __ATOMIC_RELAXED, __HIP_MEMORY_SCOPE_AGENT); }
__device__ __forceinline__ unsigned xb_xcc_id() { return (unsigned)__builtin_amdgcn_s_getreg((3 << 11) | 20) & 0xFu; }
#define XB_SPIN(cond, bar) do { unsigned _sp = 0; while (cond) { __builtin_amdgcn_s_sleep(1); \
    if ((++_sp & 255u) == 0u) { if (xb_ld(&(bar)[XB_TMO])) break; if (_sp > XB_SPIN_CAP) { atomicAdd(&(bar)[XB_TMO], 1u); break; } } } } while (0)
struct XcdBarrier { unsigned* bar; unsigned x; volatile PG8_LAS unsigned* st; };
__device__ __forceinline__ XcdBarrier xcd_barrier_post(unsigned* bar, volatile PG8_LAS unsigned* st) {
    XcdBarrier b; b.bar = bar; b.x = xb_xcc_id(); b.st = st;
    if (threadIdx.x == 0) (void)xb_add(&bar[XB_XCNT(b.x)], 1u);
    return b;
}
__device__ __forceinline__ void xcd_barrier_complete(unsigned* bar, unsigned x, unsigned& nloc, unsigned& nx) {
    const unsigned G = gridDim.x * gridDim.y * gridDim.z;
    unsigned sum, cnt, mine, sp = 0u;
    for (;;) {
        sum = 0u; cnt = 0u; mine = 0u;
#pragma unroll
        for (unsigned j = 0; j < 16; ++j) { const unsigned c = xb_ld(&bar[XB_XCNT(j)]); sum += c; cnt += (c > 0u) ? 1u : 0u; mine = (j == x) ? c : mine; }
        if (sum == G) break;
        __builtin_amdgcn_s_sleep(1);
        if ((++sp & 255u) == 0u) { if (xb_ld(&bar[XB_TMO])) break; if (sp > XB_SPIN_CAP) { atomicAdd(&bar[XB_TMO], 1u); break; } }
    }
    nloc = mine > 0u ? mine : 1u; nx = cnt > 0u ? cnt : 1u;
}
__device__ __forceinline__ void xcd_barrier(const XcdBarrier& b) {
    asm volatile("s_waitcnt vmcnt(0)" ::: "memory");
    __syncthreads();
    if (threadIdx.x == 0) {
        unsigned* bar = b.bar;
        __builtin_amdgcn_s_waitcnt(0);
        unsigned nloc = b.st[0], nx = b.st[1];
        if (nloc == 0u) { xcd_barrier_complete(bar, b.x, nloc, nx); b.st[0] = nloc; b.st[1] = nx; }
        const unsigned old = xb_add(&bar[XB_XSUB(b.x)], 1u);
        const unsigned gen = old / nloc;
        if (old + 1u == (gen + 1u) * nloc) {
            __builtin_amdgcn_fence(__ATOMIC_RELEASE, "agent");
            asm volatile("s_waitcnt vmcnt(0)" ::: "memory");
            const unsigned og = xb_add(&bar[XB_TOP], 1u);
            const unsigned tg = og / nx;
            if (og + 1u == (tg + 1u) * nx) xb_add(&bar[XB_TOPGEN], 1u);
            else XB_SPIN(xb_ld(&bar[XB_TOPGEN]) == tg, bar);
            __builtin_amdgcn_fence(__ATOMIC_ACQUIRE, "agent");
            xb_add(&bar[XB_XGEN(b.x)], 1u);
            asm volatile("s_waitcnt vmcnt(0)" ::: "memory");
        } else {
            XB_SPIN(xb_ld(&bar[XB_XGEN(b.x)]) == gen, bar);
            __builtin_amdgcn_fence(__ATOMIC_ACQUIRE, "agent");
            asm volatile("s_waitcnt vmcnt(0)" ::: "memory");
        }
    }
    __syncthreads();
}

struct EpiResB {
    static constexpr bool PERM = true, AFTER_DRAIN = false;
    bf16_t* C; int ldc; const float* X;
    __device__ __forceinline__ void operator()(const pg8::f32x4 (&acc)[2][2][4][2], const pg8::Unit& u, int wr, int wc, int fr, int fq) const {
        using namespace pg8;
        const int row0 = u.pm * BM + wr * 64 + fr, col0 = u.pn * BM + wc * 32 + 8 * fq;
#pragma unroll
        for (int ai = 0; ai < 2; ++ai) {
            f32x4 xv[4][2][2];
#pragma unroll
            for (int m = 0; m < 4; ++m) { const float* xp = X + (size_t)(row0 + ai * HALF + m * 16) * ldc + col0;
#pragma unroll
                for (int bj = 0; bj < 2; ++bj)
#pragma unroll
                    for (int n = 0; n < 2; ++n) xv[m][bj][n] = __builtin_nontemporal_load((const f32x4*)(xp + bj * HALF + n * 4)); }
#pragma unroll
            for (int m = 0; m < 4; ++m) { bf16_t* rowp = C + (size_t)(row0 + ai * HALF + m * 16) * ldc + col0;
#pragma unroll
                for (int bj = 0; bj < 2; ++bj) { const f32x4 v0 = acc[ai][bj][m][0] + ALPHA * xv[m][bj][0], v1 = acc[ai][bj][m][1] + ALPHA * xv[m][bj][1];
                    u32x4 wv; wv.x = pkbf(v0[0], v0[1]); wv.y = pkbf(v0[2], v0[3]); wv.z = pkbf(v1[0], v1[1]); wv.w = pkbf(v1[2], v1[3]);
                    *(u32x4*)(rowp + bj * HALF) = wv; } } }
    }
};
struct EpiRes {
    static constexpr bool PERM = false, AFTER_DRAIN = false;
    float* C; int ldc; const float* X;
    __device__ __forceinline__ void operator()(const pg8::f32x4 (&acc)[2][2][4][2], const pg8::Unit& u, int wr, int wc, int fr, int fq) const {
        using namespace pg8;
        const int row0 = u.pm * BM + wr * 64 + fr, col0 = u.pn * BM + wc * 32 + 4 * fq;
#pragma unroll
        for (int ai = 0; ai < 2; ++ai) {
            f32x4 xv[4][2][2];
#pragma unroll
            for (int m = 0; m < 4; ++m) { const float* xp = X + (size_t)(row0 + ai * HALF + m * 16) * ldc + col0;
#pragma unroll
                for (int bj = 0; bj < 2; ++bj)
#pragma unroll
                    for (int n = 0; n < 2; ++n) xv[m][bj][n] = __builtin_nontemporal_load((const f32x4*)(xp + bj * HALF + n * 16)); }
#pragma unroll
            for (int m = 0; m < 4; ++m) { float* rowp = C + (size_t)(row0 + ai * HALF + m * 16) * ldc + col0;
#pragma unroll
                for (int bj = 0; bj < 2; ++bj)
#pragma unroll
                    for (int n = 0; n < 2; ++n) *(f32x4*)(rowp + bj * HALF + n * 16) = acc[ai][bj][m][n] + ALPHA * xv[m][bj][n]; } }
    }
};
struct OneUnit { int pm, pn;
    __device__ bool next(int i, pg8::Unit& u) const { if (i) return false; u.pm = pm; u.pn = pn; return true; }
    __device__ __forceinline__ void a_ready(const pg8::Unit&) const {}
    __device__ __forceinline__ void done(const pg8::Unit&) const {} };
__global__ __launch_bounds__(512, 2) void mega(Params p) {
    extern __shared__ __attribute__((aligned(16))) unsigned char shm[];
    cg::grid_group grid = cg::this_grid();
    if (p.ph_lo < 0) grid.sync();
    const bool fused = p.ph_hi - p.ph_lo > 1;
    volatile PG8_LAS unsigned* st = (volatile PG8_LAS unsigned*)(PG8_LAS unsigned char*)(shm + LDS_STAGE);
    if (threadIdx.x == 0) { st[0] = 0u; st[1] = 0u; }
    __syncthreads();
    XcdBarrier xb; xb.bar = (unsigned*)(p.ws + WS_BAR); xb.x = 0; xb.st = st;
    if (fused) xb = xcd_barrier_post((unsigned*)(p.ws + WS_BAR), st);
#define SEAM() xcd_barrier(xb)
#ifndef PROBE_REP
#define PROBE_REP 0
#endif
#define RUN_PHASE(i, ...) if (p.ph_lo <= (i) && (i) < p.ph_hi) { if ((i) > p.ph_lo) SEAM(); __VA_ARGS__ if ((PROBE_REP >> (i)) & 1) { SEAM(); if ((i) == 2) { if (blockIdx.x == 0 && threadIdx.x == 0) *(unsigned*)(p.ws + WS_CTR) = 0u; SEAM(); } __VA_ARGS__ } }
    RUN_PHASE(0, phase0(p, shm);)
    RUN_PHASE(1, { pg8::Gemm g{(const bf16_t*)(p.ws + WS_A1), (const bf16_t*)(p.ws + WS_BT1), MROWS, NPROJ, DM, DM};
        pg8::StaticOrder S; S.init(MROWS, NPROJ, (int)gridDim.x, (int)blockIdx.x);
        EpiProj E{(bf16_t*)(p.ws + WS_PROJ), p.lb_logits};
        pg8::gemm_phase<EpiProj, pg8::StaticOrder, false>((PG8_LAS unsigned char*)shm, g, S, E, nullptr); })
    RUN_PHASE(2, phase2(p, shm);)
    RUN_PHASE(4, {
        { pg8::Gemm g{(const bf16_t*)(p.ws + WS_MIX), (const bf16_t*)(p.ws + WS_BT2), PROWS, DM, DMIX, DMIX};
          pg8::StaticOrder S; S.init(PROWS, DM, (int)gridDim.x, (int)blockIdx.x);
          EpiResB E{(bf16_t*)(p.ws + WS_H), DM, p.x_prompt};
          pg8::gemm_phase<EpiResB, pg8::StaticOrder, false>((PG8_LAS unsigned char*)shm, g, S, E, nullptr); }
        for (int q = blockIdx.x; q < 256; q += gridDim.x) { const int kp = q & 7, tile = q >> 3;
          __syncthreads();
          pg8::Gemm g{(const bf16_t*)(p.ws + WS_MIX) + (size_t)PROWS * DMIX + kp * 512, (const bf16_t*)(p.ws + WS_BT2) + kp * 512, SROWS, DM, 512, DMIX};
          OneUnit S{tile >> 3, tile & 7};
          pg8::EpiBf16<0> E{(bf16_t*)(p.ws + WS_HPART) + (size_t)kp * SROWS * DM, DM, nullptr, 0, 0};
          pg8::gemm_phase<pg8::EpiBf16<0>, OneUnit, false>((PG8_LAS unsigned char*)shm, g, S, E, nullptr); } })
    RUN_PHASE(5, phase5(p, shm);)
#ifdef PROBE_SYNC
    for (int i = 0; i < PROBE_SYNC; ++i) SEAM();
#endif
#undef RUN_PHASE
}

#ifndef N_LAUNCHES
#define N_LAUNCHES 1
#endif
extern "C" void kernel_launch(void* const* d_in, const int* in_sizes, int n_in, void* d_out, int out_size, void* d_ws, size_t ws_size, hipStream_t stream) {
    static int grid = 0;
    if (grid == 0) {
        if (n_in != 12 || ws_size < WS_END) { fprintf(stderr, "kernel_launch: unexpected shapes (n_in %d, ws %zu < %zu)\n", n_in, ws_size, (size_t)WS_END); grid = -1; return; }
        int dev = 0, cus = 0, per_cu = 0;
        hipGetDevice(&dev); hipDeviceGetAttribute(&cus, hipDeviceAttributeMultiprocessorCount, dev);
        if (hipFuncSetAttribute((const void*)mega, hipFuncAttributeMaxDynamicSharedMemorySize, LDS_BYTES) != hipSuccess) { fprintf(stderr, "kernel_launch: hipFuncSetAttribute failed\n"); grid = -1; return; }
        if (hipOccupancyMaxActiveBlocksPerMultiprocessor(&per_cu, (const void*)mega, 512, LDS_BYTES) != hipSuccess || per_cu < 1) { fprintf(stderr, "kernel_launch: occupancy query says %d\n", per_cu); per_cu = 1; }
        (void)hipGetLastError();
        grid = cus * 1;
        if (grid <= 0) grid = 256;
    }
    if (grid < 0) return;
    Params p{};
    p.x_prompt = (const float*)d_in[0]; p.x_sample = (const float*)d_in[1]; p.state_conv = (const float*)d_in[2]; p.state_hgrn = (const float*)d_in[3];
    p.w_in = (const float*)d_in[4]; p.conv_w = (const float*)d_in[5]; p.norm_a = (const float*)d_in[6]; p.lb_logits = (const float*)d_in[7]; p.norm_b = (const float*)d_in[8];
    p.w_out = (const float*)d_in[9]; p.ln_gain = (const float*)d_in[10]; p.ln_bias = (const float*)d_in[11];
    p.out = (float*)d_out; p.ws = (unsigned char*)d_ws;
    (void)hipMemsetAsync((unsigned char*)d_ws + WS_CTR, 0, WS_END - WS_CTR, stream);
#if N_LAUNCHES == 1
    p.ph_lo = 0; p.ph_hi = 6;
    void* args[] = {&p};
    hipError_t e = hipLaunchCooperativeKernel((const void*)mega, dim3(grid), dim3(512), args, LDS_BYTES, stream);
    if (e != hipSuccess) fprintf(stderr, "cooperative launch failed: %s (grid %d)\n", hipGetErrorString(e), grid);
#else
    for (int i = 0; i < 6; ++i) { p.ph_lo = i; p.ph_hi = i + 1; hipLaunchKernelGGL(mega, dim3(grid), dim3(512), LDS_BYTES, stream, p); }
#endif
}
```
